# Optimizing an MI355X kernel written in HIP

```python
import math
import jax, jax.numpy as jnp
from jax import lax
import numpy as np

D_MODEL = 1024
BATCH = 8
SEQ = 8192
DEPTH = 1

MLA_HEADS = 8
Q_LORA = 256
KV_LORA = 128
QK_NOPE = 64
QK_ROPE = 32
V_HEAD = 64
QK_HEAD = QK_NOPE + QK_ROPE
ROPE_THETA = 10000.0
Q_BLOCK = 128
M_HEADS = 4
M_HEAD = 128
M_WIDTH = M_HEADS * M_HEAD
CONV_K = 5
CHUNK = 128
FFN_DIM = 2816
EPS = 1e-6
IN_SPLITS = (Q_LORA, KV_LORA, QK_ROPE, M_WIDTH, M_WIDTH, 4 * M_HEADS, D_MODEL, D_MODEL)
IN_DIM = Q_LORA + KV_LORA + QK_ROPE + 2 * M_WIDTH + 4 * M_HEADS + 2 * D_MODEL

kernel_name = "hybrid_mla_mlstm_macaron_block"


def rmsnorm(x, w):
    xf = x.astype(jnp.float32)
    y = xf * lax.rsqrt(jnp.mean(xf * xf, axis=-1, keepdims=True) + EPS)
    return (y * w.astype(jnp.float32)).astype(x.dtype)


def swiglu(x, w_gate, w_up, w_down):
    return (jax.nn.silu(x @ w_gate) * (x @ w_up)) @ w_down


def rope_tables(positions):
    half = QK_ROPE // 2
    inv = ROPE_THETA ** (-jnp.arange(half, dtype=jnp.float32) / half)
    ang = positions.astype(jnp.float32)[..., None] * inv
    return jnp.cos(ang)[:, :, None, :], jnp.sin(ang)[:, :, None, :]


def apply_rope(x, cos, sin):
    half = QK_ROPE // 2
    x1, x2 = x[..., :half], x[..., half:]
    c, s = cos.astype(x.dtype), sin.astype(x.dtype)
    return jnp.concatenate([x1 * c - x2 * s, x2 * c + x1 * s], axis=-1)


def block_attention(q, k, v):
    B, H, S, dq = q.shape
    nb = S // Q_BLOCK
    qb = q.reshape(B, H, nb, Q_BLOCK, dq).transpose(2, 0, 1, 3, 4)
    scale = QK_HEAD ** -0.5

    def one(qblk):
        s = jnp.einsum('bhqd,bhkd->bhqk', qblk, k).astype(jnp.float32) * scale
        p = jax.nn.softmax(s, axis=-1)
        return jnp.einsum('bhqk,bhkd->bhqd', p.astype(v.dtype), v)

    o = lax.map(one, qb)
    return o.transpose(1, 0, 3, 2, 4).reshape(B, S, H * v.shape[-1])


def mla_branch(c_q, c_kv, k_pe, positions, q_a_norm_w, w_uq, kv_a_norm_w, w_uk, w_uv,
               q_norm_w, k_norm_w):
    B, S, _ = c_q.shape
    q = (rmsnorm(c_q, q_a_norm_w) @ w_uq).reshape(B, S, MLA_HEADS, QK_HEAD)
    ckv = rmsnorm(c_kv, kv_a_norm_w)
    k_nope = (ckv @ w_uk).reshape(B, S, MLA_HEADS, QK_NOPE)
    v = (ckv @ w_uv).reshape(B, S, MLA_HEADS, V_HEAD)
    k = jnp.concatenate(
        [k_nope, jnp.broadcast_to(k_pe[:, :, None, :], (B, S, MLA_HEADS, QK_ROPE))], axis=-1)
    q = rmsnorm(q, q_norm_w)
    k = rmsnorm(k, k_norm_w)
    cos, sin = rope_tables(positions)
    q = jnp.concatenate([q[..., :QK_NOPE], apply_rope(q[..., QK_NOPE:], cos, sin)], axis=-1)
    k = jnp.concatenate([k[..., :QK_NOPE], apply_rope(k[..., QK_NOPE:], cos, sin)], axis=-1)
    return block_attention(q.transpose(0, 2, 1, 3), k.transpose(0, 2, 1, 3),
                           v.transpose(0, 2, 1, 3))


def centred_conv(x, w, b):
    C = x.shape[-1]
    y = lax.conv_general_dilated(
        x, w.astype(x.dtype)[:, None, :], window_strides=(1,),
        padding=[(CONV_K // 2, CONV_K // 2)], dimension_numbers=('NWC', 'WIO', 'NWC'),
        feature_group_count=C)
    return y + b


def mlstm_scan(q, k, v, i_pre, logf):
    B, H, S, dk = q.shape
    dv = v.shape[-1]
    nc = S // CHUNK
    to_chunks = lambda t: jnp.moveaxis(t.reshape(B, H, nc, CHUNK, *t.shape[3:]), 2, 0)
    mask = jnp.tril(jnp.ones((CHUNK, CHUNK), dtype=bool))

    def step(carry, inp):
        C, n, m = carry
        qc, kc, vc, ic, fc = inp
        b = jnp.cumsum(fc, axis=-1)
        logw = b[..., :, None] - b[..., None, :] + ic[..., None, :]
        logw = jnp.where(mask, logw, -jnp.inf)
        inter = b + m[..., None]
        m_t = jnp.maximum(jnp.max(logw, axis=-1), inter)
        sc = jnp.einsum('bhtd,bhsd->bhts', qc, kc) * jnp.exp(logw - m_t[..., None])
        inter_w = jnp.exp(inter - m_t)
        num = jnp.einsum('bhts,bhsv->bhtv', sc, vc) + inter_w[..., None] * jnp.einsum('bhtk,bhkv->bhtv', qc, C)
        den = jnp.sum(sc, axis=-1) + inter_w * jnp.einsum('bhtk,bhk->bht', qc, n)
        h = num / jnp.maximum(jnp.abs(den), jnp.exp(-m_t))[..., None]
        bL = b[..., -1]
        g = bL[..., None] - b + ic
        m_new = jnp.maximum(bL + m, jnp.max(g, axis=-1))
        decay = jnp.exp(bL + m - m_new)
        ws = jnp.exp(g - m_new[..., None])
        C_new = decay[..., None, None] * C + jnp.einsum('bhs,bhsk,bhsv->bhkv', ws, kc, vc)
        n_new = decay[..., None] * n + jnp.einsum('bhs,bhsk->bhk', ws, kc)
        return (C_new, n_new, m_new), h

    init = (jnp.zeros((B, H, dk, dv), jnp.float32), jnp.zeros((B, H, dk), jnp.float32),
            jnp.zeros((B, H), jnp.float32))
    _, hs = lax.scan(step, init, (to_chunks(q), to_chunks(k), to_chunks(v),
                                  to_chunks(i_pre), to_chunks(logf)))
    return jnp.moveaxis(hs, 0, 2).reshape(B, H, S, dv)


def mlstm_branch(m_in, o_pre, gates, conv_w, conv_b, w_mq, w_mk, w_mv, b_igate, b_fgate,
                 m_norm_w, m_skip):
    B, S, _ = m_in.shape
    xc = jax.nn.silu(centred_conv(m_in, conv_w, conv_b))
    xch = xc.reshape(B, S, M_HEADS, M_HEAD)
    xmh = m_in.reshape(B, S, M_HEADS, M_HEAD)
    f32 = jnp.float32
    q = jnp.einsum('bshd,hde->bhse', xch, w_mq).astype(f32)
    k = (jnp.einsum('bshd,hde->bhse', xch, w_mk) * (M_HEAD ** -0.5)).astype(f32)
    v = jnp.einsum('bshd,hde->bhse', xmh, w_mv).astype(f32)
    gf = gates.astype(f32)
    i_pre = (gf[..., :2 * M_HEADS] + b_igate.astype(f32)).transpose(0, 2, 1)
    logf = jax.nn.log_sigmoid(gf[..., 2 * M_HEADS:] + b_fgate.astype(f32)).transpose(0, 2, 1)
    flip = lambda t: jnp.flip(t, axis=2)
    h_fwd = mlstm_scan(q, k, v, i_pre[:, :M_HEADS], logf[:, :M_HEADS])
    h_bwd = flip(mlstm_scan(flip(q), flip(k), flip(v), flip(i_pre[:, M_HEADS:]),
                            flip(logf[:, M_HEADS:])))
    h_cell = (h_fwd + h_bwd).transpose(0, 2, 1, 3)
    hn = rmsnorm(h_cell, m_norm_w.reshape(M_HEADS, M_HEAD)).reshape(B, S, M_WIDTH)
    return jax.nn.sigmoid(o_pre) * (hn.astype(m_in.dtype) + m_skip * xc)


def setup_inputs(seed: int = 0) -> dict:
    key = jax.random.key(seed)
    ks = iter(jax.random.split(key, 48))
    f32 = jnp.float32
    nrm = lambda shape, fan_in: jax.random.normal(next(ks), shape, f32) * fan_in ** -0.5
    gain = lambda shape: 1.0 + 0.02 * jax.random.normal(next(ks), shape, f32)
    L = DEPTH
    x = jax.random.normal(next(ks), (BATCH, SEQ, D_MODEL), f32)
    offs = jax.random.randint(next(ks), (BATCH, 1), 0, 1024, dtype=jnp.int32)
    positions = jnp.arange(SEQ, dtype=jnp.int32)[None, :] + offs
    f_bias = jnp.tile(jnp.linspace(3.0, 6.0, M_HEADS, dtype=f32), 2)[None, :]
    return {
        "x": x,
        "positions": positions,
        "ffn1_norm_w": gain((L, D_MODEL)),
        "ffn1_w_gate": nrm((L, D_MODEL, FFN_DIM), D_MODEL),
        "ffn1_w_up": nrm((L, D_MODEL, FFN_DIM), D_MODEL),
        "ffn1_w_down": nrm((L, FFN_DIM, D_MODEL), FFN_DIM),
        "mix_norm_w": gain((L, D_MODEL)),
        "w_in": nrm((L, D_MODEL, IN_DIM), D_MODEL),
        "q_a_norm_w": gain((L, Q_LORA)),
        "w_uq": nrm((L, Q_LORA, MLA_HEADS * QK_HEAD), Q_LORA),
        "kv_a_norm_w": gain((L, KV_LORA)),
        "w_uk": nrm((L, KV_LORA, MLA_HEADS * QK_NOPE), KV_LORA),
        "w_uv": nrm((L, KV_LORA, MLA_HEADS * V_HEAD), KV_LORA),
        "q_norm_w": gain((L, QK_HEAD)),
        "k_norm_w": gain((L, QK_HEAD)),
        "w_branch_a": nrm((L, MLA_HEADS * V_HEAD, D_MODEL), MLA_HEADS * V_HEAD),
        "conv_w": nrm((L, CONV_K, M_WIDTH), CONV_K),
        "conv_b": 0.02 * jax.random.normal(next(ks), (L, M_WIDTH), f32),
        "w_mq": nrm((L, M_HEADS, M_HEAD, M_HEAD), M_HEAD),
        "w_mk": nrm((L, M_HEADS, M_HEAD, M_HEAD), M_HEAD),
        "w_mv": nrm((L, M_HEADS, M_HEAD, M_HEAD), M_HEAD),
        "b_igate": 0.1 * jax.random.normal(next(ks), (L, 2 * M_HEADS), f32),
        "b_fgate": f_bias + 0.1 * jax.random.normal(next(ks), (L, 2 * M_HEADS), f32),
        "m_norm_w": gain((L, M_WIDTH)),
        "m_skip": gain((L, M_WIDTH)),
        "w_branch_b": nrm((L, M_WIDTH, D_MODEL), M_WIDTH),
        "w_out": nrm((L, D_MODEL, D_MODEL), D_MODEL),
        "ffn2_norm_w": gain((L, D_MODEL)),
        "ffn2_w_gate": nrm((L, D_MODEL, FFN_DIM), D_MODEL),
        "ffn2_w_up": nrm((L, D_MODEL, FFN_DIM), D_MODEL),
        "ffn2_w_down": nrm((L, FFN_DIM, D_MODEL), FFN_DIM),
        "final_norm_w": gain((L, D_MODEL)),
    }


def reference(x, positions, ffn1_norm_w, ffn1_w_gate, ffn1_w_up, ffn1_w_down, mix_norm_w, w_in,
              q_a_norm_w, w_uq, kv_a_norm_w, w_uk, w_uv, q_norm_w, k_norm_w, w_branch_a,
              conv_w, conv_b, w_mq, w_mk, w_mv, b_igate, b_fgate, m_norm_w, m_skip, w_branch_b,
              w_out, ffn2_norm_w, ffn2_w_gate, ffn2_w_up, ffn2_w_down, final_norm_w):
    split_points = [sum(IN_SPLITS[:j + 1]) for j in range(len(IN_SPLITS) - 1)]
    for l in range(DEPTH):
        h = rmsnorm(x, ffn1_norm_w[l])
        x = x + 0.5 * swiglu(h, ffn1_w_gate[l], ffn1_w_up[l], ffn1_w_down[l])
        h = rmsnorm(x, mix_norm_w[l])
        p = h @ w_in[l]
        c_q, c_kv, k_pe, m_in, o_pre, gates, g_a, g_b = jnp.split(p, split_points, axis=-1)
        a = mla_branch(c_q, c_kv, k_pe, positions, q_a_norm_w[l], w_uq[l], kv_a_norm_w[l],
                       w_uk[l], w_uv[l], q_norm_w[l], k_norm_w[l])
        bm = mlstm_branch(m_in, o_pre, gates, conv_w[l], conv_b[l], w_mq[l], w_mk[l], w_mv[l],
                          b_igate[l], b_fgate[l], m_norm_w[l], m_skip[l])
        merged = jax.nn.sigmoid(g_a) * (a @ w_branch_a[l]) + jax.nn.sigmoid(g_b) * (bm @ w_branch_b[l])
        x = x + merged @ w_out[l]
        h = rmsnorm(x, ffn2_norm_w[l])
        x = x + 0.5 * swiglu(h, ffn2_w_gate[l], ffn2_w_up[l], ffn2_w_down[l])
        x = rmsnorm(x, final_norm_w[l])
    return x
```

```cpp
#include <hip/hip_runtime.h>
#include <cstdio>
#include <cstdint>

#define LAS __attribute__((address_space(3)))
#define GAS __attribute__((address_space(1)))
typedef unsigned short bf16_t;
typedef short bf16x8 __attribute__((ext_vector_type(8)));
typedef short s16x4 __attribute__((ext_vector_type(4)));
typedef float f32x4 __attribute__((ext_vector_type(4)));
typedef float f32x2 __attribute__((ext_vector_type(2)));
typedef float f32x16 __attribute__((ext_vector_type(16)));
typedef unsigned u32x4 __attribute__((ext_vector_type(4)));
typedef unsigned u32x2 __attribute__((ext_vector_type(2)));
typedef int i32x8 __attribute__((ext_vector_type(8)));
typedef int i32x4_t __attribute__((ext_vector_type(4)));

constexpr int BATCH = 8, SEQ = 8192, DM = 1024, M = BATCH * SEQ;
constexpr int FFN = 2816, NGU = 2 * FFN;
constexpr int IN_DIM = 3504;
constexpr float EPS = 1e-6f;
constexpr float LOG2E = 1.4426950408889634f;

typedef __bf16 bf16x2_t __attribute__((ext_vector_type(2)));
__device__ __forceinline__ unsigned cvt_pk_bf16(float lo, float hi) { f32x2 v = {lo, hi}; bf16x2_t b = __builtin_convertvector(v, bf16x2_t); return __builtin_bit_cast(unsigned, b); }
__device__ __forceinline__ bf16_t f2bf(float f) { return (bf16_t)(cvt_pk_bf16(f, 0.f) & 0xffffu); }
__device__ __forceinline__ float bf2f(bf16_t b) { return __uint_as_float((unsigned)b << 16); }
__device__ __forceinline__ void unpack8(const u32x4 w, float (&f)[8]) {
    f[0] = __uint_as_float(w.x << 16); f[1] = __uint_as_float(w.x & 0xffff0000u);
    f[2] = __uint_as_float(w.y << 16); f[3] = __uint_as_float(w.y & 0xffff0000u);
    f[4] = __uint_as_float(w.z << 16); f[5] = __uint_as_float(w.z & 0xffff0000u);
    f[6] = __uint_as_float(w.w << 16); f[7] = __uint_as_float(w.w & 0xffff0000u);
}
__device__ __forceinline__ u32x4 pack8(const float (&f)[8]) {
    u32x4 w; w.x = cvt_pk_bf16(f[0], f[1]); w.y = cvt_pk_bf16(f[2], f[3]); w.z = cvt_pk_bf16(f[4], f[5]); w.w = cvt_pk_bf16(f[6], f[7]); return w;
}
__device__ __forceinline__ unsigned pack4_fp8(float a, float b, float c, float d) { int w = 0; w = __builtin_amdgcn_cvt_pk_fp8_f32(a, b, w, false); w = __builtin_amdgcn_cvt_pk_fp8_f32(c, d, w, true); return (unsigned)w; }
__device__ __forceinline__ unsigned pack4_bf8(float a, float b, float c, float d) { int w = 0; w = __builtin_amdgcn_cvt_pk_bf8_f32(a, b, w, false); w = __builtin_amdgcn_cvt_pk_bf8_f32(c, d, w, true); return (unsigned)w; }
__device__ __forceinline__ float rsq_(float x) { return __builtin_amdgcn_rsqf(x); }
__device__ __forceinline__ float sigmoidf_(float x) { return __builtin_amdgcn_rcpf(1.f + __expf(-x)); }
__device__ __forceinline__ int lane_id() { unsigned z = 0u; asm volatile("" : "+v"(z)); return (int)__builtin_amdgcn_mbcnt_hi(~0u, __builtin_amdgcn_mbcnt_lo(~0u, z)); }
__device__ __forceinline__ float wave_sum(float v) {
#pragma unroll
    for (int o = 1; o < 64; o <<= 1) v += __shfl_xor(v, o);
    return v;
}

namespace pg8 {
constexpr int BM = 256, BK = 64, HALF = 128, HTB = HALF * BK * 2, STAGE_BYTES = 8 * HTB, NXCD = 8, WGM = 8;
__host__ __device__ __forceinline__ int lds_byte(int r, int c) { const int st = (r >> 4) * 2 + (c >> 5), rr = r & 15, cc = c & 31, ob = rr * 64 + cc * 2; return st * 1024 + (ob ^ (((ob >> 9) & 1) << 5)); }
__host__ __device__ __forceinline__ void stage_rc(int b, int& R, int& C) { const int st = b / 1024, sb = b % 1024, swz = sb ^ (((sb >> 9) & 1) << 5); R = (st >> 1) * 16 + swz / 64; C = (st & 1) * 32 + (swz % 64) / 2; }
__host__ __device__ __forceinline__ int perm32(int rho) { const int n = rho >> 4, i = rho & 15; return 8 * (i >> 2) + 4 * n + (i & 3); }

struct Unit { int pm, pn; };
template <bool F8> struct Frag;
template <> struct Frag<false> { bf16x8 v[2]; };
template <> struct Frag<true> { i32x8 w; };
struct Gemm { const bf16_t* A; const bf16_t* Bt; int M, N, K, lda, ldb, ao1, ao2; };

struct StaticOrder {
    int nM, nN, nwg, G, c, n_all, hv;
    __host__ __device__ void init(int M_, int N_, int G_, int c_) { nM = M_ / BM; nN = N_ / BM; nwg = nM * nN; G = G_; c = c_; n_all = -1; hv = -1; }
    __host__ __device__ bool next(int i, Unit& u) const {
        long L = (long)i * G + c;
        if (n_all >= 0 && i >= n_all) { if (hv < 0) return false; L = (long)n_all * G + (long)(i - n_all) * (G / 2) + hv; }
        if (L >= nwg) return false;
        int wgid = (int)L; { const int q = nwg / NXCD, r = nwg % NXCD, xcd = wgid % NXCD, off = wgid / NXCD; wgid = (xcd < r ? xcd * (q + 1) : r * (q + 1) + (xcd - r) * q) + off; }
        const int nig = WGM * nN, gid = wgid / nig, fm = gid * WGM, gsz = (nM - fm) < WGM ? (nM - fm) : WGM;
        u.pm = fm + ((wgid % nig) % gsz); u.pn = (wgid % nig) / gsz; return true;
    }
};

template <class Epi, bool F8 = false>
__device__ __forceinline__ void gemm_phase(LAS unsigned char* lds, const Gemm g, const StaticOrder& S, const Epi& E, const int wv) {
    int lane = lane_id(); asm volatile("" : "+v"(lane));
    const int wid = wv, tid = wv * 64 + lane, wr = wid >> 2, wc = wid & 3, fr = lane & 15, fq = lane >> 4;
    const int K = g.K; int nt = K / BK; if constexpr (F8) asm volatile("" : "+s"(nt));
    unsigned voffA[2], voffB[2];
#pragma unroll
    for (int i = 0; i < 2; ++i) { int R, C; stage_rc(tid * 16 + i * 8192, R, C); const int Rb = (R & ~31) + perm32(R & 31);
        voffA[i] = (unsigned)(R * g.lda + C) * 2u; voffB[i] = (unsigned)(Rb * g.ldb + C) * 2u; }
    const size_t kstep = (size_t)(BK * 2);
    const size_t hstepA = (size_t)HALF * g.lda * 2, hstepB = (size_t)HALF * g.ldb * 2;
    const size_t tstepA = 2 * hstepA, tstepB = 2 * hstepB;
    const unsigned ldsw = (unsigned)wid * 1024u;
    const int aoff = lds_byte(wr * 64 + fr, fq * 8), boff = lds_byte(wc * 32 + fr, fq * 8);
#define PG8_SA(b, h) (((b) * 2 + (h)) * HTB)
#define PG8_SB(b, h) ((4 + (b) * 2 + (h)) * HTB)
#define PG8_STAGE(bufoff, gbase, voff) do { _Pragma("unroll") for (int _i = 0; _i < 2; ++_i) { \
        unsigned keep_; const unsigned dst_ = (unsigned)(__UINTPTR_TYPE__)(lds + (bufoff) + ldsw + _i * 8192);        \
        asm volatile("s_mov_b32 %0, m0\n\ts_mov_b32 m0, %3\n\ts_nop 0\n\tglobal_load_lds_dwordx4 %1, %2\n\ts_mov_b32 m0, %0" : "=&s"(keep_) : "v"((voff)[_i]), "s"((const char*)(gbase)), "s"(dst_) : "memory"); } } while (0)
#define PG8_LD1(dst, base) do { if constexpr (F8) { const i32x4_t lo_ = *(const LAS i32x4_t*)(base), hi_ = *(const LAS i32x4_t*)((base) + 1024); dst.w = __builtin_shufflevector(lo_, hi_, 0, 1, 2, 3, 4, 5, 6, 7); } \
        else { dst.v[0] = *(const LAS bf16x8*)(base); dst.v[1] = *(const LAS bf16x8*)((base) + 1024); } } while (0)
#define PG8_LDA(dst, b, h) do { _Pragma("unroll") for (int m = 0; m < 4; ++m) PG8_LD1(dst[m], lds + PG8_SA(b, h) + aoff + m * 2048); } while (0)
#define PG8_LDB(dst, b, h) do { _Pragma("unroll") for (int n = 0; n < 2; ++n) PG8_LD1(dst[n], lds + PG8_SB(b, h) + boff + n * 2048); } while (0)
#define PG8_MMA(ai, bj, At, Bt) do { __builtin_amdgcn_s_setprio(1); \
        if constexpr (F8) { _Pragma("unroll") for (int m = 0; m < 4; ++m) _Pragma("unroll") for (int n = 0; n < 2; ++n) \
            acc[ai][bj][m][n] = __builtin_amdgcn_mfma_scale_f32_16x16x128_f8f6f4(Bt[n].w, At[m].w, acc[ai][bj][m][n], 0, 0, 0, 0, 0, 0); } \
        else { _Pragma("unroll") for (int m = 0; m < 4; ++m) _Pragma("unroll") for (int n = 0; n < 2; ++n) _Pragma("unroll") for (int k = 0; k < 2; ++k) \
            acc[ai][bj][m][n] = __builtin_amdgcn_mfma_f32_16x16x32_bf16(Bt[n].v[k], At[m].v[k], acc[ai][bj][m][n], 0, 0, 0); } \
        __builtin_amdgcn_s_setprio(0); } while (0)
#define PG8_WAIT_V(n) asm volatile("s_waitcnt vmcnt(" #n ")" ::: "memory")
#define PG8_WAIT_L(n) asm volatile("s_waitcnt lgkmcnt(" #n ")" ::: "memory")
#define PG8_BAR __builtin_amdgcn_s_barrier()
#define PG8_SCHED __builtin_amdgcn_sched_barrier(0)
#define PG8_AOFF(u) ((size_t)(((u).pn & 1) * g.ao1 + ((u).pn >> 2) * g.ao2) * 2)
    Unit cur, nxt; int ui = 0;
    if (!S.next(0, cur)) return;
    f32x4 acc[2][2][4][2];
#pragma unroll
    for (int a = 0; a < 2; ++a)
#pragma unroll
        for (int b = 0; b < 2; ++b)
#pragma unroll
            for (int m = 0; m < 4; ++m)
#pragma unroll
                for (int n = 0; n < 2; ++n) acc[a][b][m][n] = (f32x4){0.f, 0.f, 0.f, 0.f};
    Frag<F8> At[4], B0[2], B1[2];
    const char* cA = (const char*)g.A + (size_t)cur.pm * tstepA + PG8_AOFF(cur); const char* cB = (const char*)g.Bt + (size_t)cur.pn * tstepB;
    PG8_STAGE(PG8_SB(0, 0), cB, voffB); PG8_STAGE(PG8_SB(0, 1), cB + hstepB, voffB); PG8_STAGE(PG8_SA(0, 0), cA, voffA); PG8_STAGE(PG8_SA(0, 1), cA + hstepA, voffA);
    if (wr == 1) PG8_BAR;
    PG8_WAIT_V(2); PG8_BAR;
    PG8_STAGE(PG8_SB(1, 0), cB + kstep, voffB); PG8_STAGE(PG8_SA(1, 0), cA + kstep, voffA); PG8_STAGE(PG8_SB(1, 1), cB + hstepB + kstep, voffB);
    PG8_WAIT_V(6); PG8_BAR;
    for (;;) {
        const bool has_next = S.next(ui + 1, nxt);
        const char* nA = has_next ? (const char*)g.A + (size_t)nxt.pm * tstepA + PG8_AOFF(nxt) : cA; const char* nB = has_next ? (const char*)g.Bt + (size_t)nxt.pn * tstepB : cB;
        for (int t = 0; t < nt; t += 2) {
            if constexpr (Epi::MIDK) { if (t == (nt >> 1)) { const int l2 = lane_id(); E.mid(acc, cur, wr, wc, l2 & 15, l2 >> 4); } }
            const bool last = (t == nt - 2);
            const char* a1 = cA + (size_t)(t + 1) * kstep;
            const char* a2 = last ? nA : cA + (size_t)(t + 2) * kstep; const char* b2 = last ? nB : cB + (size_t)(t + 2) * kstep;
            const char* a3 = a2 + kstep; const char* b3 = b2 + kstep;
            PG8_LDB(B0, 0, 0); PG8_LDB(B1, 0, 1); PG8_SCHED; PG8_LDA(At, 0, 0); PG8_STAGE(PG8_SA(1, 1), a1 + hstepA, voffA);
            PG8_WAIT_V(8); PG8_WAIT_L(0); PG8_BAR; PG8_MMA(0, 0, At, B0); PG8_MMA(0, 1, At, B1); PG8_BAR; PG8_SCHED;
            PG8_LDA(At, 0, 1); PG8_STAGE(PG8_SB(0, 0), b2, voffB); PG8_STAGE(PG8_SB(0, 1), b2 + hstepB, voffB); PG8_STAGE(PG8_SA(0, 0), a2, voffA);
            PG8_WAIT_V(8); PG8_WAIT_L(0); PG8_BAR; PG8_MMA(1, 0, At, B0); PG8_MMA(1, 1, At, B1); PG8_BAR; PG8_SCHED;
            PG8_LDB(B0, 1, 0); PG8_LDB(B1, 1, 1); PG8_SCHED; PG8_LDA(At, 1, 0); PG8_STAGE(PG8_SA(0, 1), a2 + hstepA, voffA);
            PG8_WAIT_V(8); PG8_WAIT_L(0); PG8_BAR; PG8_MMA(0, 0, At, B0); PG8_MMA(0, 1, At, B1); PG8_BAR; PG8_SCHED;
            PG8_LDA(At, 1, 1); PG8_STAGE(PG8_SB(1, 0), b3, voffB); PG8_STAGE(PG8_SB(1, 1), b3 + hstepB, voffB); PG8_STAGE(PG8_SA(1, 0), a3, voffA);
            PG8_WAIT_V(8); PG8_WAIT_L(0); PG8_BAR; PG8_MMA(1, 0, At, B0); PG8_MMA(1, 1, At, B1); PG8_BAR; PG8_SCHED;
        }
        if (wr == 0) PG8_BAR;
        { const int l2 = lane_id(); E(acc, cur, wr, wc, l2 & 15, l2 >> 4); }
        if (!has_next) break;
#pragma unroll
        for (int a = 0; a < 2; ++a)
#pragma unroll
            for (int b = 0; b < 2; ++b)
#pragma unroll
                for (int m = 0; m < 4; ++m)
#pragma unroll
                    for (int n = 0; n < 2; ++n) acc[a][b][m][n] = (f32x4){0.f, 0.f, 0.f, 0.f};
        cur = nxt; cA = nA; cB = nB; ++ui;
        if (wr == 1) PG8_BAR;
    }
    PG8_WAIT_V(0);
    PG8_BAR;
#undef PG8_SA
#undef PG8_SB
#undef PG8_STAGE
#undef PG8_LDA
#undef PG8_LDB
#undef PG8_MMA
#undef PG8_LD1
#undef PG8_WAIT_V
#undef PG8_WAIT_L
#undef PG8_BAR
#undef PG8_SCHED
#undef PG8_AOFF
}

#define EPI_ROWS(ai, m) (u.pm * BM + (ai) * HALF + wr * 64 + (m) * 16 + fr)
#define SSQ_RSTD(v) rsq_((v) * (1.f / DM) + EPS)
struct EpiSwiglu {
    static constexpr bool MIDK = false;
    bf16_t* O; const float* rstd;
    __device__ __forceinline__ void operator()(const f32x4 (&acc)[2][2][4][2], const Unit& u, int wr, int wc, int fr, int fq) const {
        const int col0 = u.pn * HALF + wc * 32 + 8 * fq; float rsv[2][4];
#pragma unroll
        for (int ai = 0; ai < 2; ++ai)
#pragma unroll
            for (int m = 0; m < 4; ++m) rsv[ai][m] = rstd[EPI_ROWS(ai, m)];
#pragma unroll
        for (int ai = 0; ai < 2; ++ai)
#pragma unroll
            for (int m = 0; m < 4; ++m) { const int row = EPI_ROWS(ai, m); const float a_ = rsv[ai][m] * (1.f / DM) + EPS, c1 = -LOG2E * rsq_(a_); float o[8];
#pragma unroll
                for (int n = 0; n < 2; ++n)
#pragma unroll
                    for (int j = 0; j < 4; ++j) { const float g_ = acc[ai][0][m][n][j], e_ = __builtin_amdgcn_exp2f(g_ * c1); o[4 * n + j] = (g_ * acc[ai][1][m][n][j]) * __builtin_amdgcn_rcpf(__builtin_fmaf(e_, a_, a_)); }
                *(u32x4*)(O + (size_t)row * FFN + col0) = pack8(o); }
    }
};
template <bool OUT_F32, bool OUT_F8 = false> struct EpiRes {
    static constexpr bool MIDK = false;
    const bf16_t* res; void* out; float* ss; float alpha; unsigned char* out8;
    __device__ __forceinline__ void operator()(const f32x4 (&acc)[2][2][4][2], const Unit& u, int wr, int wc, int fr, int fq) const {
        u32x4 rv[2][4][2];
#pragma unroll
        for (int ai = 0; ai < 2; ++ai)
#pragma unroll
            for (int m = 0; m < 4; ++m)
#pragma unroll
                for (int bj = 0; bj < 2; ++bj) rv[ai][m][bj] = *(const u32x4*)(res + (size_t)EPI_ROWS(ai, m) * DM + u.pn * BM + bj * HALF + wc * 32 + 8 * fq);
#pragma unroll
        for (int ai = 0; ai < 2; ++ai) {
#pragma unroll
            for (int m = 0; m < 4; ++m) { const int row = EPI_ROWS(ai, m); float sq = 0.f;
#pragma unroll
                for (int bj = 0; bj < 2; ++bj) { const size_t off = (size_t)row * DM + u.pn * BM + bj * HALF + wc * 32 + 8 * fq; float r[8]; unpack8(rv[ai][m][bj], r);
#pragma unroll
                    for (int n = 0; n < 2; ++n)
#pragma unroll
                        for (int j = 0; j < 4; ++j) { const float v = r[4 * n + j] + alpha * acc[ai][bj][m][n][j]; r[4 * n + j] = v; sq += v * v; }
                    if (OUT_F32) { *(f32x4*)((float*)out + off) = (f32x4){r[0], r[1], r[2], r[3]}; *(f32x4*)((float*)out + off + 4) = (f32x4){r[4], r[5], r[6], r[7]}; }
                    else *(u32x4*)((bf16_t*)out + off) = pack8(r);
                    if (OUT_F8) *(u32x2*)(out8 + off) = (u32x2){pack4_fp8(r[0], r[1], r[2], r[3]), pack4_fp8(r[4], r[5], r[6], r[7])}; }
                sq += __shfl_xor(sq, 16); sq += __shfl_xor(sq, 32);
                if (fq == 0) (void)__hip_atomic_fetch_add(ss + row, sq, __ATOMIC_RELAXED, __HIP_MEMORY_SCOPE_AGENT); } }
    }
};
template <class CFG> struct EpiStore {
    static constexpr bool MIDK = false;
    unsigned char* ws; const float* rowscale; float* gates;
    __device__ __forceinline__ void operator()(const f32x4 (&acc)[2][2][4][2], const Unit& u, int wr, int wc, int fr, int fq) const {
        const int grp = u.pn >> 1; const size_t boff = grp == 0 ? CFG::off0 : (grp == 1 ? CFG::off1 : CFG::off2); const int ld = grp == 0 ? CFG::ld0 : (grp == 1 ? CFG::ld1 : CFG::ld2);
        const int cb = (grp == 0 ? CFG::c0 : (grp == 1 ? CFG::c1 : CFG::c2)) + (u.pn & 1) * BM; const bool hp = (grp == 0) && CFG::HP;
        bf16_t* base = (bf16_t*)(ws + boff); float rsv[2][4];
#pragma unroll
        for (int ai = 0; ai < 2; ++ai)
#pragma unroll
            for (int m = 0; m < 4; ++m) rsv[ai][m] = CFG::RS ? rowscale[EPI_ROWS(ai, m)] : 1.f;
#pragma unroll
        for (int ai = 0; ai < 2; ++ai)
#pragma unroll
            for (int m = 0; m < 4; ++m) { const int row = EPI_ROWS(ai, m); const float rs = CFG::SSQ ? SSQ_RSTD(rsv[ai][m]) : rsv[ai][m];
#pragma unroll
                for (int bj = 0; bj < 2; ++bj) { const int lc = bj * HALF + wc * 32 + 8 * fq; int col = cb + lc; if (hp) col = (col >> 6) * 96 + (col & 63); float o[8];
#pragma unroll
                    for (int n = 0; n < 2; ++n)
#pragma unroll
                        for (int j = 0; j < 4; ++j) o[4 * n + j] = acc[ai][bj][m][n][j] * rs;
                    *(u32x4*)(base + (size_t)row * ld + col) = pack8(o);
                    if (CFG::GATES && u.pn == 1 && bj == 1 && wc == 1 && fq < 2) { float* gp = gates + (size_t)row * 16 + 8 * fq;
                        *(f32x4*)gp = (f32x4){o[0], o[1], o[2], o[3]}; *(f32x4*)(gp + 4) = (f32x4){o[4], o[5], o[6], o[7]}; } } }
    }
};
constexpr int SIG_SPLIT_PM = 192;
struct EpiSig {
    static constexpr bool MIDK = false;
    bf16_t* O0; bf16_t* O1; const float* rstd; float post;
    __device__ __forceinline__ void operator()(const f32x4 (&acc)[2][2][4][2], const Unit& u, int wr, int wc, int fr, int fq) const {
        float rsv[2][4]; bf16_t* const O = u.pm < SIG_SPLIT_PM ? O0 : O1;
#pragma unroll
        for (int ai = 0; ai < 2; ++ai)
#pragma unroll
            for (int m = 0; m < 4; ++m) rsv[ai][m] = rstd[EPI_ROWS(ai, m)];
#pragma unroll
        for (int ai = 0; ai < 2; ++ai)
#pragma unroll
            for (int m = 0; m < 4; ++m) { const int row = EPI_ROWS(ai, m); const float c1 = -LOG2E * post * SSQ_RSTD(rsv[ai][m]);
#pragma unroll
                for (int bj = 0; bj < 2; ++bj) { const int col = u.pn * BM + bj * HALF + wc * 32 + 8 * fq; float o[8];
#pragma unroll
                    for (int n = 0; n < 2; ++n)
#pragma unroll
                        for (int j = 0; j < 4; ++j) o[4 * n + j] = __builtin_amdgcn_rcpf(1.f + __builtin_amdgcn_exp2f(acc[ai][bj][m][n][j] * c1));
                    *(u32x4*)(O + (size_t)row * 2048 + col) = pack8(o); } }
    }
};
struct EpiMerge {
    static constexpr bool MIDK = true;
    bf16_t* T; const bf16_t* sig0; const bf16_t* sig1;
    __device__ __forceinline__ void mid(f32x4 (&acc)[2][2][4][2], const Unit& u, int wr, int wc, int fr, int fq) const {
        const bf16_t* const sig = u.pm < SIG_SPLIT_PM ? sig0 : sig1;
#pragma unroll
        for (int ai = 0; ai < 2; ++ai) { u32x4 sa[4][2], sb[4][2];
#pragma unroll
            for (int m = 0; m < 4; ++m)
#pragma unroll
                for (int bj = 0; bj < 2; ++bj) { const size_t o = (size_t)EPI_ROWS(ai, m) * 2048 + u.pn * BM + bj * HALF + wc * 32 + 8 * fq;
                    sa[m][bj] = *(const u32x4*)(sig + o); sb[m][bj] = *(const u32x4*)(sig + o + 1024); }
#pragma unroll
            for (int m = 0; m < 4; ++m)
#pragma unroll
                for (int bj = 0; bj < 2; ++bj) { float a[8], b[8]; unpack8(sa[m][bj], a); unpack8(sb[m][bj], b);
#pragma unroll
                    for (int n = 0; n < 2; ++n)
#pragma unroll
                        for (int j = 0; j < 4; ++j) acc[ai][bj][m][n][j] *= b[4 * n + j] * __builtin_amdgcn_rcpf(fmaxf(a[4 * n + j], 1e-30f)); } }
    }
    __device__ __forceinline__ void operator()(const f32x4 (&acc)[2][2][4][2], const Unit& u, int wr, int wc, int fr, int fq) const {
        const bf16_t* const sig = u.pm < SIG_SPLIT_PM ? sig0 : sig1;
        u32x4 sa[2][4][2];
#pragma unroll
        for (int ai = 0; ai < 2; ++ai)
#pragma unroll
            for (int m = 0; m < 4; ++m)
#pragma unroll
                for (int bj = 0; bj < 2; ++bj) sa[ai][m][bj] = *(const u32x4*)(sig + (size_t)EPI_ROWS(ai, m) * 2048 + u.pn * BM + bj * HALF + wc * 32 + 8 * fq);
#pragma unroll
        for (int ai = 0; ai < 2; ++ai) {
#pragma unroll
            for (int m = 0; m < 4; ++m)
#pragma unroll
                for (int bj = 0; bj < 2; ++bj) { float a[8], o[8]; unpack8(sa[ai][m][bj], a);
#pragma unroll
                    for (int n = 0; n < 2; ++n)
#pragma unroll
                        for (int j = 0; j < 4; ++j) o[4 * n + j] = acc[ai][bj][m][n][j] * fmaxf(a[4 * n + j], 1e-30f);
                    *(u32x4*)(T + (size_t)EPI_ROWS(ai, m) * DM + u.pn * BM + bj * HALF + wc * 32 + 8 * fq) = pack8(o); } }
    }
};
#undef EPI_ROWS
#undef SSQ_RSTD
}

namespace att {
constexpr int NW = 8, QBLK = 32, KVBLK = 64;
constexpr int LDQ = 768, LDK = 768, LDV = 512, LDO = 1024;
constexpr float THR = 4.f;
#define SBAR() __builtin_amdgcn_sched_barrier(0)
__device__ __forceinline__ int crow(int r, int hi) { return (r & 3) + 8 * (r >> 2) + 4 * hi; }
constexpr int KSLOT = 8192, VSLOT = 4096, L2_K = 0, L2_V = 4 * KSLOT, L2_WS = L2_V + 3 * VSLOT, L2_BYTES = L2_WS + NW * 64 * 4;
__device__ __forceinline__ void glds16(const void* gsrc, unsigned lds_dst) { unsigned keep;
  asm volatile("s_mov_b32 %0, m0\n\ts_mov_b32 m0, %2\n\ts_nop 0\n\tglobal_load_lds_dwordx4 %1, off\n\ts_mov_b32 m0, %0" : "=&s"(keep) : "v"(gsrc), "s"(lds_dst) : "memory"); }
__device__ __forceinline__ void pv2(f32x16* o, LAS const unsigned char* va, LAS const unsigned char* vb_, const i32x8 pa) {
#pragma unroll
  for (int d0 = 0; d0 < 2; ++d0) { const u32x4 lo = *(const LAS u32x4*)(va + d0 * 2048), hi_ = *(const LAS u32x4*)(vb_ + d0 * 2048);
    const i32x8 v8 = (i32x8){(int)lo.x, (int)lo.y, (int)lo.z, (int)lo.w, (int)hi_.x, (int)hi_.y, (int)hi_.z, (int)hi_.w};
    o[d0] = __builtin_amdgcn_mfma_scale_f32_32x32x64_f8f6f4(pa, v8, o[d0], 1  , 0  , 0, 0x7f7f7f7f, 0, 0x7f7f7f7f); }
}
template <bool FIRST> __device__ __forceinline__ void decideSM2(f32x16& p0, f32x16& p1, float& m_reg, float& l_reg, float& alpha) {
  float pmax = p0[0];
#pragma unroll
  for (int r = 1; r < 16; ++r) pmax = fmaxf(pmax, p0[r]);
#pragma unroll
  for (int r = 0; r < 16; ++r) pmax = fmaxf(pmax, p1[r]);
  { auto rr = __builtin_amdgcn_permlane32_swap(__float_as_uint(pmax), __float_as_uint(pmax), false, false);
    pmax = fmaxf(__uint_as_float(rr[0]), __uint_as_float(rr[1])); }
  alpha = 1.f;
  if (FIRST || !__builtin_expect(__all(pmax <= THR), 1)) {
    const float dl = FIRST ? pmax : fmaxf(pmax, 0.f);
    m_reg += dl;
#pragma unroll
    for (int r = 0; r < 16; ++r) { p0[r] -= dl; p1[r] -= dl; }
    if (!FIRST) { alpha = __builtin_amdgcn_exp2f(-dl); l_reg *= alpha; }
  }
}
__device__ __forceinline__ void finishSM2(f32x16& p0, f32x16& p1, float& l_reg, i32x8& pa) {
#pragma unroll
  for (int r = 0; r < 16; ++r) p0[r] = __builtin_amdgcn_exp2f(p0[r]);
#pragma unroll
  for (int r = 0; r < 16; ++r) p1[r] = __builtin_amdgcn_exp2f(p1[r]);
  float ps = 0;
#pragma unroll
  for (int r = 0; r < 16; ++r) ps += p0[r];
#pragma unroll
  for (int r = 0; r < 16; ++r) ps += p1[r];
  { auto rr = __builtin_amdgcn_permlane32_swap(__float_as_uint(ps), __float_as_uint(ps), false, false);
    ps = __uint_as_float(rr[0]) + __uint_as_float(rr[1]); }
  l_reg += ps;
#define PK4(P, B) (int)pack4_bf8(P[B], P[B + 1], P[B + 2], P[B + 3])
  pa = (i32x8){PK4(p0, 0), PK4(p0, 4), PK4(p0, 8), PK4(p0, 12), PK4(p1, 0), PK4(p1, 4), PK4(p1, 8), PK4(p1, 12)};
#undef PK4
}
constexpr int SC_ONE = 0x7f7f7f7f, SC_EIGHTH = 0x7c7c7c7c;
constexpr float POFF = -4.f;
template <bool ZC = false> __device__ __forceinline__ void qkt2r(f32x16& p0, f32x16& p1, const i32x8* kf8, LAS const unsigned char* kpE, LAS const unsigned char* kpO, const i32x8 q8, const bf16x8* qr, const float nm) {
  f32x16 negm;
#pragma unroll
  for (int r = 0; r < 16; ++r) negm[r] = ZC ? POFF : nm;
  const bf16x8 k8 = *(const LAS bf16x8*)(kpE), k9 = *(const LAS bf16x8*)(kpE + 2048), k10 = *(const LAS bf16x8*)(kpO), k11 = *(const LAS bf16x8*)(kpO + 2048);
  p0 = __builtin_amdgcn_mfma_scale_f32_32x32x64_f8f6f4(kf8[0], q8, negm, 0, 0, 0, SC_ONE, 0, SC_EIGHTH);
  p1 = __builtin_amdgcn_mfma_scale_f32_32x32x64_f8f6f4(kf8[1], q8, negm, 0, 0, 0, SC_ONE, 0, SC_EIGHTH);
  p0 = __builtin_amdgcn_mfma_f32_32x32x16_bf16(k8, qr[0], p0, 0, 0, 0); p1 = __builtin_amdgcn_mfma_f32_32x32x16_bf16(k9, qr[0], p1, 0, 0, 0);
  p0 = __builtin_amdgcn_mfma_f32_32x32x16_bf16(k10, qr[1], p0, 0, 0, 0); p1 = __builtin_amdgcn_mfma_f32_32x32x16_bf16(k11, qr[1], p1, 0, 0, 0);
}
__device__ __forceinline__ void kload8(i32x8* kf8, LAS const unsigned char* kpa, LAS const unsigned char* kpb) {
#pragma unroll
  for (int b = 0; b < 2; ++b) { const u32x4 lo = *(const LAS u32x4*)(kpa + b * 2048), hi_ = *(const LAS u32x4*)(kpb + b * 2048);
    kf8[b] = (i32x8){(int)lo.x, (int)lo.y, (int)lo.z, (int)lo.w, (int)hi_.x, (int)hi_.y, (int)hi_.z, (int)hi_.w}; }
}
template <bool NOMAX> __device__ __forceinline__ void attn_unit2(const bf16_t* __restrict__ Qb, const bf16_t* __restrict__ Kh, const unsigned char* __restrict__ Vt, bf16_t* __restrict__ Ob, int seq, char* shm, const int wv) {
  int lane = lane_id(); asm volatile("" : "+v"(lane));
  const int wid = wv, r32 = lane & 31, hi = lane >> 5;
  const unsigned lds0 = (unsigned)(uintptr_t)shm;
  LAS const unsigned char* shm3 = (LAS const unsigned char*)shm;
  float* ws = (float*)(shm + L2_WS) + wid * 64; float* li_l = ws; float* al_l = ws + 32;
  const int kcl = (lane & 3) ^ ((lane >> 4) & 3);
  const bf16_t* ksrcA = Kh + (long)((wid & 3) * 16 + (lane >> 2)) * LDK + (wid >> 2) * 64 + kcl * 8;
  const unsigned char* vsrc = Vt + (wid & 3) * 1024 + lane * 16; const bool vw = wid < 4;
  const unsigned kdstA = lds0 + L2_K + wid * 1024, vdst = lds0 + L2_V + (wid & 3) * 1024;
#define DMA_K(t, ks) glds16(ksrcA + (long)(t) * KVBLK * LDK, (unsigned)__builtin_amdgcn_readfirstlane(kdstA + (ks)))
#define DMA_V(t, vs) do { if (vw) glds16(vsrc + (long)(t) * 4096, (unsigned)__builtin_amdgcn_readfirstlane(vdst + (vs))); } while (0)
#define WAITBAR(N) asm volatile("s_waitcnt vmcnt(" #N ") lgkmcnt(0)\n\ts_barrier" ::: "memory")
#define WAITBAR2() do { if (vw) WAITBAR(2); else WAITBAR(1); } while (0)
  const int kswz = (r32 >> 2) & 3, krow = (r32 >> 4) * 1024 + (r32 & 15) * 64;
  LAS const unsigned char* kpa = shm3 + L2_K + krow + (((2 * hi) ^ kswz) * 16);
  LAS const unsigned char* kpb = shm3 + L2_K + krow + (((2 * hi + 1) ^ kswz) * 16);
  LAS const unsigned char* kp0 = shm3 + L2_K + 4096 + krow + ((hi ^ kswz) * 16);
  LAS const unsigned char* kp1 = shm3 + L2_K + 4096 + krow + (((2 + hi) ^ kswz) * 16);
  LAS const unsigned char* va0 = shm3 + L2_V + r32 * 64 + (((2 * hi) ^ kswz) * 16);
  LAS const unsigned char* vb0 = shm3 + L2_V + r32 * 64 + (((2 * hi + 1) ^ kswz) * 16);
  const int NT = seq / KVBLK;
  DMA_K(0, 0); DMA_V(0, 0); DMA_K(1, KSLOT); DMA_K(2, 2 * KSLOT);
  float m_reg = 0.f, l_reg = 0; f32x16 o[2] = {}; bf16x8 qr[2]; i32x8 q8, kf[2];
  const bf16_t* Qw = Qb + (long)(wid * QBLK + r32) * LDQ;
  { const u32x4 qa = *reinterpret_cast<const u32x4*>((const char*)Qw + hi * 32), qb_ = *reinterpret_cast<const u32x4*>((const char*)Qw + hi * 32 + 16);
    q8 = (i32x8){(int)qa.x, (int)qa.y, (int)qa.z, (int)qa.w, (int)qb_.x, (int)qb_.y, (int)qb_.z, (int)qb_.w}; }
#pragma unroll
  for (int d0 = 0; d0 < 2; ++d0) qr[d0] = *reinterpret_cast<const bf16x8*>(Qw + 64 + hi * 8 + d0 * 16);
#define RESC2(a) do { if (__any((a) < 1.f)) { if (hi == 0) al_l[r32] = (a); asm volatile("s_waitcnt lgkmcnt(0)" ::: "memory"); \
    _Pragma("unroll") for (int d = 0; d < 2; ++d) _Pragma("unroll") for (int r = 0; r < 16; ++r) o[d][r] *= al_l[crow(r, hi)]; } } while (0)
  f32x16 pA0, pA1, pB0, pB1; float alA, alB; i32x8 pa;
  asm volatile("" : "+v"(qr[0]), "+v"(qr[1]), "+v"(q8));
  WAITBAR(0);
  int k0s = 0, k1s = KSLOT, k2s = 2 * KSLOT, k3s = 3 * KSLOT, vm1s = 2 * VSLOT, v0s = 0, v1s = VSLOT;
#define ROT2() do { const int tk = k0s; k0s = k1s; k1s = k2s; k2s = k3s; k3s = tk; const int tv = vm1s; vm1s = v0s; v0s = v1s; v1s = tv; } while (0)
  kload8(kf, kpa + k0s, kpb + k0s); asm volatile("s_waitcnt lgkmcnt(0)\n\ts_barrier" ::: "memory");
  DMA_K(3, k3s); DMA_V(1, v1s);
  qkt2r<true>(pA0, pA1, kf, kp0 + k0s, kp1 + k0s, q8, qr, 0.f); SBAR(); kload8(kf, kpa + k1s, kpb + k1s); if (!NOMAX) decideSM2<true>(pA0, pA1, m_reg, l_reg, alA);
  WAITBAR2(); ROT2();
  for (int j = 1; j + 1 < NT; j += 2) {
    if (j + 3 < NT) { DMA_K(j + 3, k3s); DMA_V(j + 1, v1s); } else { DMA_V(j + 1, v1s); }
    SBAR(); qkt2r<NOMAX>(pB0, pB1, kf, kp0 + k0s, kp1 + k0s, q8, qr, -m_reg);
    finishSM2(pA0, pA1, l_reg, pa); SBAR();
    pv2(o, va0 + vm1s, vb0 + vm1s, pa); kload8(kf, kpa + k1s, kpb + k1s); if (!NOMAX) { decideSM2<false>(pB0, pB1, m_reg, l_reg, alB);
    RESC2(alB); } if (j + 3 < NT) WAITBAR2(); else WAITBAR(0); ROT2();
    if (j + 4 < NT) { DMA_K(j + 4, k3s); DMA_V(j + 2, v1s); } else if (j + 2 < NT) { DMA_V(j + 2, v1s); }
    SBAR(); qkt2r<NOMAX>(pA0, pA1, kf, kp0 + k0s, kp1 + k0s, q8, qr, -m_reg);
    finishSM2(pB0, pB1, l_reg, pa); SBAR();
    pv2(o, va0 + vm1s, vb0 + vm1s, pa); if (j + 2 < NT) kload8(kf, kpa + k1s, kpb + k1s); if (!NOMAX) { decideSM2<false>(pA0, pA1, m_reg, l_reg, alA);
    RESC2(alA); } if (j + 4 < NT) WAITBAR2(); else WAITBAR(0); ROT2();
  }
  SBAR(); qkt2r<NOMAX>(pB0, pB1, kf, kp0 + k0s, kp1 + k0s, q8, qr, -m_reg);
  finishSM2(pA0, pA1, l_reg, pa); SBAR();
  pv2(o, va0 + vm1s, vb0 + vm1s, pa); if (!NOMAX) { decideSM2<false>(pB0, pB1, m_reg, l_reg, alB);
  RESC2(alB); }
  finishSM2(pB0, pB1, l_reg, pa); SBAR();
  pv2(o, va0 + v0s, vb0 + v0s, pa);
  if (hi == 0) li_l[r32] = l_reg; asm volatile("s_waitcnt lgkmcnt(0)" ::: "memory");
  float rli[16];
#pragma unroll
  for (int r = 0; r < 16; ++r) rli[r] = __builtin_amdgcn_rcpf(li_l[crow(r, hi)]);
  bf16_t* Ow = Ob + (long)(wid * QBLK) * LDO;
#pragma unroll
  for (int r = 0; r < 16; ++r) { const int orow = crow(r, hi);
#pragma unroll
    for (int d0 = 0; d0 < 2; ++d0) Ow[(long)orow * LDO + d0 * 32 + r32] = f2bf(o[d0][r] * rli[r]); }
  asm volatile("s_waitcnt vmcnt(0) lgkmcnt(0)\n\ts_barrier" ::: "memory");
#undef DMA_K
#undef DMA_V
#undef WAITBAR
#undef WAITBAR2
#undef RESC2
#undef ROT2
}
#undef SBAR
}

namespace ml {
constexpr int LQ = 136;
constexpr int LV = 84;
constexpr int NBV = 5;
constexpr int OFF_Q = 0, OFF_K = 34816, OFF_V = 69632, OFF_CT = OFF_V + 128 * LV * 2, OFF_VEC = OFF_CT + 80 * LQ * 2;
constexpr int LDS_BYTES = OFF_VEC + 1480 * 4;
typedef short v4i16_t __attribute__((ext_vector_type(4)));
__device__ __forceinline__ s16x4 vtr(LAS const unsigned char* p) { return __builtin_bit_cast(s16x4, __builtin_amdgcn_ds_read_tr16_b64_v4i16((LAS v4i16_t*)p)); }
__device__ __forceinline__ bf16x8 tr_frag(LAS const unsigned char* base, int stride_b, int k0, int n0, int lane) {
    const int g = lane >> 4, q = (lane & 15) >> 2, p = lane & 3;
    LAS const unsigned char* a = base + (k0 + 8 * g + q) * stride_b + (n0 + 4 * p) * 2;
    const s16x4 lo = vtr(a), hi = vtr(a + 4 * stride_b);
    return (bf16x8){lo[0], lo[1], lo[2], lo[3], hi[0], hi[1], hi[2], hi[3]};
}
__device__ __forceinline__ float log_sigmoid(float x) { return fminf(x, 0.f) - log1pf(expf(-fabsf(x))); }

__device__ __forceinline__ void gate_scan(const float* __restrict__ gates, int b, int h, int dir, int cs, float bi, float bfv, float* __restrict__ gp, float* __restrict__ tp, int lane) {
    const int oc = dir ? 63 - cs : cs; const long t0 = (long)b * SEQ + (long)oc * 128;
    const int l0 = 2 * lane, l1 = l0 + 1; const long k0 = t0 + (dir ? 127 - l0 : l0), k1 = t0 + (dir ? 127 - l1 : l1);
    const float i0 = gates[k0 * 16 + dir * 4 + h] + bi, i1 = gates[k1 * 16 + dir * 4 + h] + bi;
    const float f0 = log_sigmoid(gates[k0 * 16 + 8 + dir * 4 + h] + bfv), f1 = log_sigmoid(gates[k1 * 16 + 8 + dir * 4 + h] + bfv);
    float x = f0 + f1;
#pragma unroll
    for (int o = 1; o < 64; o <<= 1) { const float y = __shfl_up(x, o); if (lane >= o) x += y; }
    const float b1 = x, b0 = x - f1;
    const float a0 = i0 - b0, a1 = i1 - b1;
    float mx = fmaxf(a0, a1);
#pragma unroll
    for (int o = 1; o < 64; o <<= 1) { const float y = __shfl_up(mx, o); if (lane >= o) mx = fmaxf(mx, y); }
    float ex = __shfl_up(mx, 1); if (lane == 0) ex = -INFINITY;
    const float pm0 = fmaxf(ex, a0), pm1 = fmaxf(pm0, a1);
    *(f32x2*)(gp + l0) = (f32x2){a0, a1}; *(f32x2*)(gp + 128 + l0) = (f32x2){b0, b1}; *(f32x2*)(gp + 256 + l0) = (f32x2){pm0, pm1};
    if (lane == 63) { tp[0] = b1; tp[1] = pm1; }
}

__device__ __forceinline__ void chain(LAS unsigned char* L, int b, int h, int sl, int dir, const bf16_t* __restrict__ mqkv,
                                      bf16_t* __restrict__ hout, const float* __restrict__ gsc, const float* __restrict__ totg, const int wv) {
    int lane = lane_id(); asm volatile("" : "+v"(lane));
    const int w = wv, tid = wv * 64 + lane, c = lane & 15, g = lane >> 4, rq = (wv < 4) ? wv : 11 - wv;
    const unsigned lbase = (unsigned)(__UINTPTR_TYPE__)L;
    LAS float* vecs = (LAS float*)(L + OFF_VEC); LAS float* mprev = vecs + 1280; LAS float* tot = mprev + 64; LAS float* dec = tot + 128;
    const size_t qoff = (size_t)h * 128, koff = 512 + (size_t)h * 128, voff = 1024 + (size_t)h * 128 + sl * 64;
    if (tid < 128) tot[tid] = totg[tid];
    __syncthreads();
    if (tid == 0) { float m = 0.f; for (int cs = 0; cs < 64; ++cs) { mprev[cs] = m; m = tot[2 * cs] + fmaxf(m, tot[2 * cs + 1]); } }
    __syncthreads();
#define ML_VECS(cs_, ga_, gb_, gpm_) do { LAS float* vb_ = vecs + ((cs_) & 1) * 640; const float mp_ = mprev[cs_]; const float pmL_ = tot[2 * (cs_) + 1]; const float ML_ = fmaxf(pmL_, mp_), M_ = fmaxf(gpm_, mp_); \
        vb_[tid] = ga_; vb_[128 + tid] = M_; vb_[256 + tid] = __expf(ga_ - ML_); vb_[384 + tid] = __expf(mp_ - M_); vb_[512 + tid] = __expf(-(gb_) - M_); if (tid == 0) dec[(cs_) & 1] = __expf(mp_ - ML_); } while (0)
    f32x4 st[NBV];
#pragma unroll
    for (int rb = 0; rb < NBV; ++rb) st[rb] = (f32x4){0.f, 0.f, 0.f, 0.f};
    bf16x8 qv[4], kv[4]; u32x4 vraw[2]; float ga = 0.f, gb = 0.f, gpm = 0.f;
    const int cc16 = tid & 15, vrow = tid >> 3, vcc = tid & 7;
    const __amdgpu_buffer_rsrc_t rsrc = __builtin_amdgcn_make_buffer_rsrc((void*)mqkv, 0, (int)((size_t)M * 1536 * 2), 0x00020000);
    const unsigned r0 = (unsigned)(tid >> 4), qk_vo = ((dir ? 31u - r0 : r0) * 1536u + (unsigned)cc16 * 8u) * 2u;
    const unsigned v_vo = ((dir ? 63u - (unsigned)vrow : (unsigned)vrow) * 1536u + (unsigned)vcc * 8u) * 2u;
#define ML_LOAD(cs_) do { const int oc_ = dir ? 63 - (cs_) : (cs_); const unsigned cb_ = (unsigned)(((size_t)b * SEQ + (size_t)oc_ * 128) * 1536 * 2); \
        _Pragma("unroll") for (int j = 0; j < 4; ++j) { const unsigned so_ = cb_ + (unsigned)((dir ? 3 - j : j) * 32 * 1536 * 2); \
            qv[j] = __builtin_bit_cast(bf16x8, __builtin_amdgcn_raw_buffer_load_b128(rsrc, qk_vo, so_ + (unsigned)qoff * 2u, 0)); \
            kv[j] = __builtin_bit_cast(bf16x8, __builtin_amdgcn_raw_buffer_load_b128(rsrc, qk_vo, so_ + (unsigned)koff * 2u, 0)); } \
        _Pragma("unroll") for (int j = 0; j < 2; ++j) { const unsigned so_ = cb_ + (unsigned)((dir ? 1 - j : j) * 64 * 1536 * 2) + (unsigned)voff * 2u; \
            vraw[j] = __builtin_bit_cast(u32x4, __builtin_amdgcn_raw_buffer_load_b128(rsrc, v_vo, so_, 0)); } \
        if (w < 2) { const float* gp_ = gsc + (size_t)(cs_) * 384 + tid; ga = gp_[0]; gb = gp_[128]; gpm = gp_[256]; } } while (0)
    ML_LOAD(0);
    if (w < 2) ML_VECS(0, ga, gb, gpm);
    __syncthreads();
    for (int cs = 0; cs < 64; ++cs) {
        int lane_ = lane; asm volatile("" : "+v"(lane_)); const int lane = lane_, c = lane & 15, g = lane >> 4, tid = w * 64 + lane, cc16 = tid & 15, vrow = tid >> 3, vcc = tid & 7; (void)vcc; (void)vrow; (void)cc16;
        const int oc = dir ? 63 - cs : cs; bf16_t* hb_ = hout + ((size_t)b * SEQ + (size_t)oc * 128) * 512;
        LAS float* vb = vecs + (cs & 1) * 640; LAS float* avec = vb; LAS float* Mvec = vb + 128; LAS float* wsvec = vb + 256; LAS float* iwvec = vb + 384; LAS float* emvec = vb + 512;
#pragma unroll
        for (int j = 0; j < 4; ++j) { const int row = (tid >> 4) + 32 * j;
            *(LAS bf16x8*)(L + OFF_Q + (row * LQ + cc16 * 8) * 2) = qv[j]; *(LAS bf16x8*)(L + OFF_K + (row * LQ + cc16 * 8) * 2) = kv[j]; }
#pragma unroll
        for (int j = 0; j < 2; ++j) { const int row = vrow + 64 * j; LAS unsigned char* vp = L + OFF_V + (row * LV + vcc * 8) * 2;
            *(LAS u32x2*)vp = (u32x2){vraw[j].x, vraw[j].y}; *(LAS u32x2*)(vp + 8) = (u32x2){vraw[j].z, vraw[j].w};
            if (vcc == 0) { LAS unsigned char* v1 = L + OFF_V + (row * LV + 64) * 2;
                *(LAS u32x2*)v1 = (u32x2){0x00003f80u, 0u}; *(LAS u32x2*)(v1 + 8) = (u32x2){0u, 0u}; *(LAS u32x2*)(v1 + 16) = (u32x2){0u, 0u}; *(LAS u32x2*)(v1 + 24) = (u32x2){0u, 0u}; } }
#pragma unroll
        for (int rb = 0; rb < NBV; ++rb)
#pragma unroll
            for (int i = 0; i < 4; ++i) *(LAS bf16_t*)(L + OFF_CT + ((16 * rb + 4 * g + i) * LQ + 16 * w + c) * 2) = f2bf(st[rb][i]);
        __syncthreads();
#define LR128(dst, addr, OFF) asm volatile("ds_read_b128 %0, %1 offset:%c2" : "=&v"(dst) : "v"(addr), "i"(OFF) : "memory")
#define LRTR(dst, addr, OFF) asm volatile("ds_read_b64_tr_b16 %0, %1 offset:%c2" : "=&v"(dst) : "v"(addr), "i"(OFF) : "memory")
#define LWAIT(N) do { asm volatile("s_waitcnt lgkmcnt(" #N ")" ::: "memory"); __builtin_amdgcn_sched_barrier(0); } while (0)
#define TRF(lo_, hi_) (bf16x8){lo_[0], lo_[1], lo_[2], lo_[3], hi_[0], hi_[1], hi_[2], hi_[3]}
        const unsigned rowA = lbase + OFF_Q + ((16 * rq + c) * LQ + 8 * g) * 2;
        const unsigned kB = lbase + OFF_K + (c * LQ + 8 * g) * 2;
        const unsigned ctB = lbase + OFF_CT + (c * LQ + 8 * g) * 2;
        const unsigned vT = lbase + OFF_V + ((8 * g + ((lane & 15) >> 2)) * LV + 4 * (lane & 3)) * 2;
        const unsigned kT = lbase + OFF_K + ((8 * g + ((lane & 15) >> 2)) * LQ + 16 * w + 4 * (lane & 3)) * 2;
        bf16x8 aq[4], fa[8], fb[8];
#define CT4(F, o, nb) do { LR128(F[(o) + 0], ctB, 4352 * (nb)); LR128(F[(o) + 1], ctB, 4352 * (nb) + 64); LR128(F[(o) + 2], ctB, 4352 * (nb) + 128); LR128(F[(o) + 3], ctB, 4352 * (nb) + 192); } while (0)
#define QCM(nb, F, o) do { QC[nb] = __builtin_amdgcn_mfma_f32_16x16x32_bf16(aq[0], F[(o)], (f32x4){0.f, 0.f, 0.f, 0.f}, 0, 0, 0); _Pragma("unroll") for (int ks = 1; ks < 4; ++ks) QC[nb] = __builtin_amdgcn_mfma_f32_16x16x32_bf16(aq[ks], F[(o) + ks], QC[nb], 0, 0, 0); } while (0)
#define KPAIR(p) do { LR128(fa[0], kB, 8704 * (p)); LR128(fa[1], kB, 8704 * (p) + 64); LR128(fa[2], kB, 8704 * (p) + 128); LR128(fa[3], kB, 8704 * (p) + 192); \
                      LR128(fa[4], kB, 8704 * (p) + 4352); LR128(fa[5], kB, 8704 * (p) + 4352 + 64); LR128(fa[6], kB, 8704 * (p) + 4352 + 128); LR128(fa[7], kB, 8704 * (p) + 4352 + 192); } while (0)
#define KPAIRB(p) do { LR128(fb[0], kB, 8704 * (p)); LR128(fb[1], kB, 8704 * (p) + 64); LR128(fb[2], kB, 8704 * (p) + 128); LR128(fb[3], kB, 8704 * (p) + 192); \
                       LR128(fb[4], kB, 8704 * (p) + 4352); LR128(fb[5], kB, 8704 * (p) + 4352 + 64); LR128(fb[6], kB, 8704 * (p) + 4352 + 128); LR128(fb[7], kB, 8704 * (p) + 4352 + 192); } while (0)
        f32x4 QC[NBV];
        LR128(aq[0], rowA, 0); LR128(aq[1], rowA, 64); LR128(aq[2], rowA, 128); LR128(aq[3], rowA, 192);
        CT4(fa, 0, 0); CT4(fa, 4, 1); CT4(fb, 0, 2); CT4(fb, 4, 3);
        LWAIT(8); QCM(0, fa, 0); QCM(1, fa, 4); __builtin_amdgcn_sched_barrier(0);
        CT4(fa, 0, 4);
        LWAIT(4); QCM(2, fb, 0); QCM(3, fb, 4); __builtin_amdgcn_sched_barrier(0);
        KPAIRB(0);
        LWAIT(8); QCM(4, fa, 0); __builtin_amdgcn_sched_barrier(0);
#undef CT4
#undef QCM
        float Mt[4], iwt[4], emt[4];
#pragma unroll
        for (int i = 0; i < 4; ++i) { const int t = 16 * rq + 4 * g + i; Mt[i] = Mvec[t]; iwt[i] = iwvec[t]; emt[i] = emvec[t]; }
#define SPAIR(p, F) do { f32x4 S0 = __builtin_amdgcn_mfma_f32_16x16x32_bf16(aq[0], F[0], (f32x4){0.f, 0.f, 0.f, 0.f}, 0, 0, 0), S1 = __builtin_amdgcn_mfma_f32_16x16x32_bf16(aq[0], F[4], (f32x4){0.f, 0.f, 0.f, 0.f}, 0, 0, 0); \
            _Pragma("unroll") for (int ks = 1; ks < 4; ++ks) { S0 = __builtin_amdgcn_mfma_f32_16x16x32_bf16(aq[ks], F[ks], S0, 0, 0, 0); S1 = __builtin_amdgcn_mfma_f32_16x16x32_bf16(aq[ks], F[4 + ks], S1, 0, 0, 0); } \
            _Pragma("unroll") for (int e = 0; e < 2; ++e) { const int nb = 2 * (p) + e; const f32x4 S = e ? S1 : S0; \
                if (nb <= rq) { const float as = avec[16 * nb + c]; \
                    _Pragma("unroll") for (int i = 0; i < 4; ++i) { float dv = __builtin_amdgcn_exp2f((as - Mt[i]) * LOG2E); if (nb == rq && c > 4 * g + i) dv = 0.f; \
                        *(LAS bf16_t*)(L + OFF_Q + ((16 * rq + 4 * g + i) * LQ + 16 * nb + c) * 2) = f2bf(S[i] * dv); } } \
                else if (nb == rq + 1) { _Pragma("unroll") for (int i = 0; i < 4; ++i) *(LAS bf16_t*)(L + OFF_Q + ((16 * rq + 4 * g + i) * LQ + 16 * nb + c) * 2) = (bf16_t)0; } } } while (0)
        const int npair = (rq >> 1) + 1;
        if (npair > 1) { KPAIR(1); LWAIT(8); } else { LWAIT(0); }
        SPAIR(0, fb);
        if (npair > 1) { if (npair > 2) { KPAIRB(2); LWAIT(8); } else { LWAIT(0); }
            SPAIR(1, fa);
            if (npair > 2) { if (npair > 3) { KPAIR(3); LWAIT(8); } else { LWAIT(0); }
                SPAIR(2, fb);
                if (npair > 3) { LWAIT(0); SPAIR(3, fa); } } }
#undef SPAIR
#undef KPAIR
#undef KPAIRB
        if (cs + 1 < 64) ML_LOAD(cs + 1);
        f32x4 N[NBV];
        asm volatile("s_waitcnt lgkmcnt(0)" ::: "memory");
        { bf16x8 sa[2]; s16x4 vlo[2][NBV], vhi[2][NBV];
#define NREADS(ks, B) do { LR128(sa[B], rowA, 64 * (ks)); _Pragma("unroll") for (int nb = 0; nb < NBV; ++nb) { LRTR(vlo[B][nb], vT, 5376 * (ks) + 32 * nb); LRTR(vhi[B][nb], vT, 5376 * (ks) + 32 * nb + 672); } } while (0)
#define NMFMA(B) do { _Pragma("unroll") for (int nb = 0; nb < NBV; ++nb) N[nb] = __builtin_amdgcn_mfma_f32_16x16x32_bf16(sa[B], TRF(vlo[B][nb], vhi[B][nb]), N[nb], 0, 0, 0); __builtin_amdgcn_sched_barrier(0); } while (0)
#define NMFMA0(B) do { _Pragma("unroll") for (int nb = 0; nb < NBV; ++nb) N[nb] = __builtin_amdgcn_mfma_f32_16x16x32_bf16(sa[B], TRF(vlo[B][nb], vhi[B][nb]), (f32x4){0.f, 0.f, 0.f, 0.f}, 0, 0, 0); __builtin_amdgcn_sched_barrier(0); } while (0)
          NREADS(0, 0);
          if (npair > 1) { NREADS(1, 1); LWAIT(11); } else { LWAIT(0); }
          NMFMA0(0);
          if (npair > 1) { if (npair > 2) { NREADS(2, 0); LWAIT(11); } else { LWAIT(0); }
              NMFMA(1);
              if (npair > 2) { if (npair > 3) { NREADS(3, 1); LWAIT(11); } else { LWAIT(0); }
                  NMFMA(0);
                  if (npair > 3) { LWAIT(0); NMFMA(1); } } }
#undef NREADS
#undef NMFMA
#undef NMFMA0
        }
#pragma unroll
        for (int i = 0; i < 4; ++i) { const int t = 16 * rq + 4 * g + i;
            const float dn = N[NBV - 1][i] + iwt[i] * QC[NBV - 1][i]; const float den = __shfl(dn, lane & 48);
            const float rd = __builtin_amdgcn_rcpf(fmaxf(fabsf(den), emt[i]));
            const unsigned ho = (unsigned)(dir ? 127 - t : t) * 512u + (unsigned)(h * 128 + sl * 64 + c);
#pragma unroll
            for (int nb = 0; nb < NBV - 1; ++nb) hb_[ho + 16 * nb] = f2bf((N[nb][i] + iwt[i] * QC[nb][i]) * rd); }
        const float decay = dec[cs & 1];
#pragma unroll
        for (int rb = 0; rb < NBV; ++rb) st[rb] = st[rb] * decay;
        { s16x4 klo[2], khi[2], vlo[2][NBV], vhi[2][NBV];
#define UREADS(ks, B) do { LRTR(klo[B], kT, 8704 * (ks)); LRTR(khi[B], kT, 8704 * (ks) + 1088); _Pragma("unroll") for (int rb = 0; rb < NBV; ++rb) { LRTR(vlo[B][rb], vT, 5376 * (ks) + 32 * rb); LRTR(vhi[B][rb], vT, 5376 * (ks) + 32 * rb + 672); } } while (0)
#define UMFMA(ks, B) do { const f32x4 w0 = *(const LAS f32x4*)(wsvec + 32 * (ks) + 8 * g), w1 = *(const LAS f32x4*)(wsvec + 32 * (ks) + 8 * g + 4); \
            float kf_[8]; unpack8(__builtin_bit_cast(u32x4, TRF(klo[B], khi[B])), kf_); \
            kf_[0] *= w0[0]; kf_[1] *= w0[1]; kf_[2] *= w0[2]; kf_[3] *= w0[3]; kf_[4] *= w1[0]; kf_[5] *= w1[1]; kf_[6] *= w1[2]; kf_[7] *= w1[3]; \
            const bf16x8 bk = __builtin_bit_cast(bf16x8, pack8(kf_)); \
            _Pragma("unroll") for (int rb = 0; rb < NBV; ++rb) st[rb] = __builtin_amdgcn_mfma_f32_16x16x32_bf16(TRF(vlo[B][rb], vhi[B][rb]), bk, st[rb], 0, 0, 0); __builtin_amdgcn_sched_barrier(0); } while (0)
          UREADS(0, 0); UREADS(1, 1); LWAIT(12); UMFMA(0, 0);
          UREADS(2, 0); LWAIT(12); UMFMA(1, 1);
          UREADS(3, 1); LWAIT(12); UMFMA(2, 0);
          LWAIT(0); UMFMA(3, 1);
#undef UREADS
#undef UMFMA
        }
#undef LR128
#undef LRTR
#undef LWAIT
#undef TRF
        if (cs + 1 < 64 && w < 2) ML_VECS(cs + 1, ga, gb, gpm);
        __syncthreads();
    }
#undef ML_VECS
#undef ML_LOAD
}
}

#define XB_TMO      128
#define XB_XCNT(j)  (256  + 64 * (j))
#define XB_XSUB(j)  (1280 + 64 * (j))
#define XB_XGEN(j)  (2304 + 64 * (j))
#define XB_TOP      3328
#define XB_TOPGEN   3392
#define XCD_BAR_WORDS 3456
#define XB_SPIN_CAP (1u << 21)

__device__ __forceinline__ unsigned xb_ld(unsigned* p)              { return __hip_atomic_load(p, __ATOMIC_RELAXED, __HIP_MEMORY_SCOPE_AGENT); }
__device__ __forceinline__ unsigned xb_add(unsigned* p, unsigned v) { return __hip_atomic_fetch_add(p, v, __ATOMIC_RELAXED, __HIP_MEMORY_SCOPE_AGENT); }
__device__ __forceinline__ unsigned xb_xcc_id() { return (unsigned)__builtin_amdgcn_s_getreg((3 << 11) | 20) & 0xFu; }
#define XB_SPIN(cond, bar) do { unsigned _sp = 0; while (cond) { __builtin_amdgcn_s_sleep(1); \
    if ((++_sp & 255u) == 0u) { if (xb_ld(&(bar)[XB_TMO])) break; if (_sp > XB_SPIN_CAP) { atomicAdd(&(bar)[XB_TMO], 1u); break; } } } } while (0)

struct XcdBarrier { unsigned* bar; unsigned x; volatile LAS unsigned* st; };

__device__ __forceinline__ XcdBarrier xcd_barrier_post(unsigned* bar, volatile LAS unsigned* st, const int wv) {
    XcdBarrier b; b.bar = bar; b.x = xb_xcc_id(); b.st = st;
    if (wv == 0 && lane_id() == 0) (void)xb_add(&bar[XB_XCNT(b.x)], 1u);
    return b;
}
__device__ __forceinline__ void xcd_barrier_complete(unsigned* bar, unsigned x, unsigned& nloc, unsigned& nx) {
    const unsigned G = gridDim.x * gridDim.y * gridDim.z;
    unsigned sum, cnt, mine, sp = 0u;
    for (;;) {
        sum = 0u; cnt = 0u; mine = 0u;
#pragma unroll
        for (unsigned j = 0; j < 16; ++j) { const unsigned c = xb_ld(&bar[XB_XCNT(j)]); sum += c; cnt += (c > 0u) ? 1u : 0u; mine = (j == x) ? c : mine; }
        if (sum == G) break;
        __builtin_amdgcn_s_sleep(1);
        if ((++sp & 255u) == 0u) { if (xb_ld(&bar[XB_TMO])) break; if (sp > XB_SPIN_CAP) { atomicAdd(&bar[XB_TMO], 1u); break; } }
    }
    nloc = mine > 0u ? mine : 1u; nx = cnt > 0u ? cnt : 1u;
}
__device__ __forceinline__ void xcd_barrier(const XcdBarrier& b, const int wv) {
    asm volatile("s_waitcnt vmcnt(0)" ::: "memory");
    __syncthreads();
    if (wv == 0 && lane_id() == 0) {
        unsigned* bar = b.bar;
        __builtin_amdgcn_s_waitcnt(0);
        unsigned nloc = b.st[0], nx = b.st[1];
        if (nloc == 0u) { xcd_barrier_complete(bar, b.x, nloc, nx); b.st[0] = nloc; b.st[1] = nx; }
        const unsigned old = xb_add(&bar[XB_XSUB(b.x)], 1u);
        const unsigned gen = old / nloc;
        if (old + 1u == (gen + 1u) * nloc) {
            __builtin_amdgcn_fence(__ATOMIC_RELEASE, "agent");
            asm volatile("s_waitcnt vmcnt(0)" ::: "memory");
            const unsigned og = xb_add(&bar[XB_TOP], 1u);
            const unsigned tg = og / nx;
            if (og + 1u == (tg + 1u) * nx) xb_add(&bar[XB_TOPGEN], 1u);
            else XB_SPIN(xb_ld(&bar[XB_TOPGEN]) == tg, bar);
            __builtin_amdgcn_fence(__ATOMIC_ACQUIRE, "agent");
            xb_add(&bar[XB_XGEN(b.x)], 1u);
            asm volatile("s_waitcnt vmcnt(0)" ::: "memory");
        } else {
            XB_SPIN(xb_ld(&bar[XB_XGEN(b.x)]) == gen, bar);
            __builtin_amdgcn_fence(__ATOMIC_ACQUIRE, "agent");
            asm volatile("s_waitcnt vmcnt(0)" ::: "memory");
        }
    }
    __syncthreads();
}

constexpr size_t MiB = 1u << 20;
constexpr size_t WS_CTL = 0, CTL_ZERO_BYTES = 1 * MiB;
constexpr size_t WS_WGU1 = 1 * MiB, WS_WD1 = 12 * MiB, WS_WGU2 = 18 * MiB, WS_WD2 = 29 * MiB, WS_WIN1 = 35 * MiB, WS_WGAB = 38 * MiB;
constexpr size_t WS_WUQ = 42 * MiB, WS_WUKV = 42 * MiB + 512 * 1024, WS_WM = 43 * MiB, WS_WA = 44 * MiB, WS_WB = 45 * MiB, WS_WOUT = 46 * MiB;
constexpr size_t WS_RSTD0 = 48 * MiB, WS_RSTD1 = WS_RSTD0 + 256 * 1024, WS_RSTD2 = WS_RSTD1 + 256 * 1024, WS_RSTDQ = WS_RSTD2 + 256 * 1024, WS_RSTDKV = 49 * MiB;
constexpr size_t WS_SS = 50 * MiB, WS_GATES = 54 * MiB;
constexpr size_t WS_X1B = 64 * MiB;
constexpr size_t WS_XB = 192 * MiB;
constexpr size_t WS_ACT = 320 * MiB;
constexpr size_t WS_PA = 320 * MiB;
constexpr size_t WS_OPRE = 384 * MiB;
constexpr size_t WS_Q = 448 * MiB;
constexpr size_t WS_K = 544 * MiB;
constexpr size_t WS_V = 640 * MiB;
constexpr size_t WS_MQKV = 704 * MiB;
constexpr size_t WS_HB = 896 * MiB;
constexpr size_t WS_GSC = 960 * MiB;
constexpr size_t WS_VT8 = 984 * MiB;
constexpr size_t WS_END = 1016 * MiB;
constexpr int CW_CHAINS = 8192;
constexpr int CW_BAR = 4096;

struct CfgWin  { static constexpr size_t off0 = WS_PA, off1 = WS_XB, off2 = WS_OPRE; static constexpr int ld0 = 512, ld1 = 1024, ld2 = 512, c0 = 0, c1 = 512, c2 = 0; static constexpr bool HP = false, GATES = true, RS = true, SSQ = true; };
struct CfgQ    { static constexpr size_t off0 = WS_Q, off1 = WS_Q, off2 = WS_Q; static constexpr int ld0 = 768, ld1 = 768, ld2 = 768, c0 = 0, c1 = 512, c2 = 0; static constexpr bool HP = false, GATES = false, RS = true, SSQ = false; };
struct CfgKV   { static constexpr size_t off0 = WS_K, off1 = WS_V, off2 = WS_V; static constexpr int ld0 = 768, ld1 = 512, ld2 = 512, c0 = 0, c1 = 0, c2 = 0; static constexpr bool HP = true, GATES = false, RS = true, SSQ = false; };
struct CfgM    { static constexpr size_t off0 = WS_MQKV, off1 = WS_MQKV, off2 = WS_MQKV; static constexpr int ld0 = 1536, ld1 = 1536, ld2 = 1536, c0 = 0, c1 = 512, c2 = 1024; static constexpr bool HP = false, GATES = false, RS = false, SSQ = false; };

constexpr int RING_BYTES = 131072, MISC_OFF = RING_BYTES + 320, LDS_BYTES = 147456;

struct Args {
    const float* x; const int* positions;
    const float *ffn1_norm_w, *ffn1_w_gate, *ffn1_w_up, *ffn1_w_down, *mix_norm_w, *w_in, *q_a_norm_w, *w_uq, *kv_a_norm_w, *w_uk, *w_uv, *q_norm_w, *k_norm_w, *w_branch_a,
                *conv_w, *conv_b, *w_mq, *w_mk, *w_mv, *b_igate, *b_fgate, *m_norm_w, *m_skip, *w_branch_b, *w_out, *ffn2_norm_w, *ffn2_w_gate, *ffn2_w_up, *ffn2_w_down, *final_norm_w;
    float* out; unsigned char* ws; int ph_lo, ph_hi;
};

template <int ID> __device__ __forceinline__ float wsrc(const Args& a, int n, int k) {
    if constexpr (ID == 0 || ID == 2) { const float* wg = ID == 0 ? a.ffn1_w_gate : a.ffn2_w_gate; const float* wu = ID == 0 ? a.ffn1_w_up : a.ffn2_w_up; const float* nw = ID == 0 ? a.ffn1_norm_w : a.ffn2_norm_w;
        const int pn = n >> 8, j = n & 255, col = 128 * pn + (j & 127); return (j < 128 ? wg : wu)[(size_t)k * FFN + col] * nw[k]; }
    else if constexpr (ID == 1 || ID == 3) { return (ID == 1 ? a.ffn1_w_down : a.ffn2_w_down)[(size_t)k * DM + n]; }
    else if constexpr (ID == 4) { int col;
        if (n < 256) col = n; else if (n < 512) { const int j = n - 256; col = j < 128 ? 256 + j : (j < 160 ? 384 + (j - 128) : (j < 176 ? 1440 + (j - 160) : -1)); }
        else if (n < 1024) col = 416 + (n - 512); else col = 928 + (n - 1024);
        return col >= 0 ? a.w_in[(size_t)k * IN_DIM + col] * a.mix_norm_w[k] : 0.f; }
    else if constexpr (ID == 5) { return a.w_in[(size_t)k * IN_DIM + 1456 + n] * a.mix_norm_w[k]; }
    else if constexpr (ID == 6) { return a.w_uq[(size_t)k * 768 + n] * a.q_a_norm_w[k]; }
    else if constexpr (ID == 7) { return (n < 512 ? a.w_uk[(size_t)k * 512 + n] : a.w_uv[(size_t)k * 512 + n - 512]) * a.kv_a_norm_w[k]; }
    else if constexpr (ID == 8) { const int T = n >> 9, r = n & 511, h = r >> 7, e = r & 127, hb = k >> 7; if (hb != (h & 1)) return 0.f;
        const float* w = T == 0 ? a.w_mq : (T == 1 ? a.w_mk : a.w_mv); const float v = w[((size_t)h * 128 + (k & 127)) * 128 + e]; return T == 1 ? v * 0.08838834764831845f : v; }
    else if constexpr (ID == 9) { return k < 512 ? a.w_branch_b[(size_t)k * DM + n] : a.w_branch_a[(size_t)(k - 512) * DM + n]; }
    else { return a.w_out[(size_t)k * DM + n]; }
}
template <int ID> __device__ __forceinline__ void wt_convert(const Args& a, bf16_t* WT, int N, int K, LAS float* scr, int gw, int NGW, int lane) {
    const int nblk = N / 32, items = (K / 64) * nblk;
    for (int item = gw; item < items; item += NGW) {
        const int kb = item / nblk, nb = item % nblk, k0 = 64 * kb, n0 = 32 * nb;
#pragma unroll 8
        for (int i = 0; i < 32; ++i) { const int kk = 2 * i + (lane >> 5); scr[kk * 33 + (lane & 31)] = wsrc<ID>(a, n0 + (lane & 31), k0 + kk); }
        asm volatile("s_waitcnt lgkmcnt(0)" ::: "memory");
        const int c = lane & 7;
#pragma unroll
        for (int j = 0; j < 4; ++j) { const int n = (lane >> 3) + 8 * j; const LAS float* s = scr + (8 * c) * 33 + n;
            u32x4 o; o.x = cvt_pk_bf16(s[0 * 33], s[1 * 33]); o.y = cvt_pk_bf16(s[2 * 33], s[3 * 33]); o.z = cvt_pk_bf16(s[4 * 33], s[5 * 33]); o.w = cvt_pk_bf16(s[6 * 33], s[7 * 33]);
            *(u32x4*)(WT + (size_t)(n0 + n) * K + k0 + 8 * c) = o; }
        asm volatile("s_waitcnt lgkmcnt(0)" ::: "memory");
    }
}

template <int ID> __device__ __forceinline__ void wt_convert8(const Args& a, unsigned char* WT8, int N, int K, float scale, LAS float* scr, int gw, int NGW, int lane) {
    const int nblk = N / 32, items = (K / 64) * nblk;
    for (int item = gw; item < items; item += NGW) {
        const int kb = item / nblk, nb = item % nblk, k0 = 64 * kb, n0 = 32 * nb;
#pragma unroll 8
        for (int i = 0; i < 32; ++i) { const int kk = 2 * i + (lane >> 5); scr[kk * 33 + (lane & 31)] = wsrc<ID>(a, n0 + (lane & 31), k0 + kk) * scale; }
        asm volatile("s_waitcnt lgkmcnt(0)" ::: "memory");
        const int c = lane & 7;
#pragma unroll
        for (int j = 0; j < 4; ++j) { const int n = (lane >> 3) + 8 * j; const LAS float* sp = scr + (8 * c) * 33 + n;
            *(u32x2*)(WT8 + (size_t)(n0 + n) * K + k0 + 8 * c) = (u32x2){pack4_fp8(sp[0 * 33], sp[1 * 33], sp[2 * 33], sp[3 * 33]), pack4_fp8(sp[4 * 33], sp[5 * 33], sp[6 * 33], sp[7 * 33])}; }
        asm volatile("s_waitcnt lgkmcnt(0)" ::: "memory");
    }
}

constexpr int NPHASE = 18;
__global__ void __launch_bounds__(512, 2) fwd_kernel(Args args) {
    extern __shared__ __attribute__((aligned(16))) unsigned char lds_raw[];
    LAS unsigned char* lds = (LAS unsigned char*)lds_raw;
    volatile LAS unsigned* MISC = (volatile LAS unsigned*)(lds + MISC_OFF);
    const int wave = __builtin_amdgcn_readfirstlane((int)threadIdx.x >> 6);
#define PH_TID() int lane = lane_id(); asm volatile("" : "+v"(lane)); const int tid = wave * 64 + lane; (void)tid
    const int G = gridDim.x, bx = blockIdx.x, vcu = (G % 8 == 0) ? (bx % 8) * (G / 8) + bx / 8 : bx;
    const int gw = vcu * 8 + wave, NGW = G * 8;
    unsigned char* ws = args.ws;
    unsigned* ctl = (unsigned*)(ws + WS_CTL);
    { PH_TID(); for (int u = tid; u < (LDS_BYTES - RING_BYTES) / 4; u += 512) ((LAS unsigned*)(lds + RING_BYTES))[u] = 0u; }
    __syncthreads();
    XcdBarrier bar = xcd_barrier_post(ctl + CW_BAR, MISC + 8, wave);
    const int lo = args.ph_lo, hi = args.ph_hi;
#define IN(k) (lo <= (k) && (k) < hi)
#define SEAM(k) do { if (IN(k) && IN((k) + 1)) xcd_barrier(bar, wave); } while (0)

#define Wgu1 ((bf16_t*)(ws + WS_WGU1))
#define Wd1 ((bf16_t*)(ws + WS_WD1))
#define Wgu2 ((bf16_t*)(ws + WS_WGU2))
#define Wd2 ((bf16_t*)(ws + WS_WD2))
#define Win1 ((bf16_t*)(ws + WS_WIN1))
#define Wgab ((bf16_t*)(ws + WS_WGAB))
#define Wuq ((bf16_t*)(ws + WS_WUQ))
#define Wukv ((bf16_t*)(ws + WS_WUKV))
#define Wm ((bf16_t*)(ws + WS_WM))
#define Wa ((bf16_t*)(ws + WS_WA))
#define Wb ((bf16_t*)(ws + WS_WB))
#define Wout ((bf16_t*)(ws + WS_WOUT))
#define rstd0 ((float*)(ws + WS_RSTD0))
#define rstd1 ((float*)(ws + WS_CTL + 256 * 1024))
#define rstd2 ((float*)(ws + WS_CTL + 512 * 1024))
#define ss3 ((float*)(ws + WS_CTL + 768 * 1024))
#define rstdq ((float*)(ws + WS_RSTDQ))
#define rstdkv ((float*)(ws + WS_RSTDKV))
#define ssb ((float*)(ws + WS_SS))
#define gatesb ((float*)(ws + WS_GATES))
#define x1b ((bf16_t*)(ws + WS_X1B))
#define xb ((bf16_t*)(ws + WS_XB))
#define xcm ((bf16_t*)(ws + WS_XB))
#define x2b ((bf16_t*)(ws + WS_XB))
#define act ((bf16_t*)(ws + WS_ACT))
#define pa ((bf16_t*)(ws + WS_PA))
#define hfb ((bf16_t*)(ws + WS_PA))
#define opre ((bf16_t*)(ws + WS_OPRE))
#define Qb ((bf16_t*)(ws + WS_Q))
#define bmb ((bf16_t*)(ws + WS_Q))
#define Kb ((bf16_t*)(ws + WS_K))
#define merged ((bf16_t*)(ws + WS_MQKV))
#define Vb ((bf16_t*)(ws + WS_V))
#define mqkv ((bf16_t*)(ws + WS_MQKV))
#define sig0_ ((bf16_t*)((unsigned char*)args.out + 64 * MiB))
#define sig1_ ((bf16_t*)(ws + WS_V) - (size_t)pg8::SIG_SPLIT_PM * 256 * 2048)
#define hbb ((bf16_t*)(ws + WS_HB))

    if (IN(0)) { PH_TID();
        LAS float* scr = (LAS float*)(lds + wave * 16384);
        wt_convert<0>(args, Wgu1, NGU, DM, scr, gw, NGW, lane);
        wt_convert<1>(args, Wd1, DM, FFN, scr, gw, NGW, lane);
        wt_convert<2>(args, Wgu2, NGU, DM, scr, gw, NGW, lane);
        wt_convert<3>(args, Wd2, DM, FFN, scr, gw, NGW, lane);
        wt_convert<4>(args, Win1, 1536, DM, scr, gw, NGW, lane);
        wt_convert8<5>(args, (unsigned char*)Wgab, 2048, DM, 32.f, scr, gw, NGW, lane);
        wt_convert<6>(args, Wuq, 768, 256, scr, gw, NGW, lane);
        wt_convert<7>(args, Wukv, 1024, 128, scr, gw, NGW, lane);
        wt_convert<8>(args, Wm, 1536, 256, scr, gw, NGW, lane);
        wt_convert<9>(args, Wa, 1024, 1024, scr, gw, NGW, lane);
        wt_convert<11>(args, Wout, 1024, 1024, scr, gw, NGW, lane);
        for (int m4 = gw * 4; m4 < M; m4 += NGW * 4) {
            f32x4 v[4][4];
#pragma unroll
            for (int u = 0; u < 4; ++u) { const f32x4* xr = (const f32x4*)(args.x + (size_t)(m4 + u) * DM) + lane;
#pragma unroll
                for (int j = 0; j < 4; ++j) v[u][j] = xr[64 * j]; }
#pragma unroll
            for (int u = 0; u < 4; ++u) { float s = 0.f;
#pragma unroll
                for (int j = 0; j < 4; ++j) s += (v[u][j][0] * v[u][j][0] + v[u][j][1] * v[u][j][1]) + (v[u][j][2] * v[u][j][2] + v[u][j][3] * v[u][j][3]);
                s = wave_sum(s);
                u32x2* o8 = (u32x2*)(xb + (size_t)(m4 + u) * DM) + lane;
#pragma unroll
                for (int j = 0; j < 4; ++j) o8[64 * j] = (u32x2){cvt_pk_bf16(v[u][j][0], v[u][j][1]), cvt_pk_bf16(v[u][j][2], v[u][j][3])};
                if (lane == 0) rstd0[m4 + u] = s; }
        }
    }
    SEAM(0);
    if (IN(1)) { pg8::Gemm g{xb, Wgu1, M, NGU, DM, DM, DM, 0, 0}; pg8::StaticOrder S; S.init(M, NGU, G, bx); pg8::EpiSwiglu E{act, rstd0}; pg8::gemm_phase(lds, g, S, E, wave); }
    SEAM(1);
    if (IN(2)) { pg8::Gemm g{act, Wd1, M, DM, FFN, FFN, FFN, 0, 0}; pg8::StaticOrder S; S.init(M, DM, G, bx); pg8::EpiRes<false, true> E{xb, x1b, rstd1, 0.5f, (unsigned char*)args.out  }; pg8::gemm_phase(lds, g, S, E, wave); }
    SEAM(2);
    if (IN(4)) { pg8::Gemm g{x1b, Win1, M, 1536, DM, DM, DM, 0, 0}; pg8::StaticOrder S; S.init(M, 1536, G, bx);
        pg8::EpiStore<CfgWin> E{ws, rstd1, gatesb}; pg8::gemm_phase(lds, g, S, E, wave); }
    SEAM(4);
    if (IN(5)) { PH_TID();
        float cw[5][8], cb[8];
#pragma unroll
        for (int j = 0; j < 5; ++j)
#pragma unroll
            for (int e = 0; e < 8; ++e) cw[j][e] = args.conv_w[j * 512 + 8 * lane + e];
#pragma unroll
        for (int e = 0; e < 8; ++e) cb[e] = args.conv_b[8 * lane + e];
        for (int blk = gw; blk < M / 32; blk += NGW) {
            const int tb = blk * 32, sb = tb & (SEQ - 1); u32x4 xr[12];
#define CONV_ROW(dst, sp_, t_) do { if ((sp_) >= 0 && (sp_) < SEQ) dst = *(const u32x4*)(xcm + (size_t)(t_) * 1024 + 512 + 8 * lane); else dst = (u32x4){0u, 0u, 0u, 0u}; } while (0)
            CONV_ROW(xr[0], sb - 2, tb - 2); CONV_ROW(xr[1], sb - 1, tb - 1); CONV_ROW(xr[2], sb, tb); CONV_ROW(xr[3], sb + 1, tb + 1);
            for (int k8 = 0; k8 < 32; k8 += 8) { const int t8 = tb + k8; u32x2 cq[8]; unsigned ckv[8];
#pragma unroll
                for (int i = 0; i < 8; ++i) { CONV_ROW(xr[4 + i], sb + k8 + i + 2, t8 + i + 2);
                    cq[i] = *(const u32x2*)(pa + (size_t)(t8 + i) * 512 + 4 * lane); ckv[i] = *(const unsigned*)(pa + (size_t)(t8 + i) * 512 + 256 + 2 * lane); }
#pragma unroll
                for (int i = 0; i < 8; ++i) { const int t = t8 + i; float y[8], xv[8];
#pragma unroll
                    for (int e = 0; e < 8; ++e) y[e] = cb[e];
#pragma unroll
                    for (int jj = 0; jj < 5; ++jj) { unpack8(xr[i + jj], xv);
#pragma unroll
                        for (int e = 0; e < 8; ++e) y[e] += cw[jj][e] * xv[e]; }
#pragma unroll
                    for (int e = 0; e < 8; ++e) y[e] = y[e] * sigmoidf_(y[e]);
                    *(u32x4*)(xcm + (size_t)t * 1024 + 8 * lane) = pack8(y);
                    const float q0 = __uint_as_float(cq[i].x << 16), q1 = __uint_as_float(cq[i].x & 0xffff0000u), q2 = __uint_as_float(cq[i].y << 16), q3 = __uint_as_float(cq[i].y & 0xffff0000u);
                    const float k0 = __uint_as_float(ckv[i] << 16), k1 = __uint_as_float(ckv[i] & 0xffff0000u);
                    const float sq = wave_sum((q0 * q0 + q1 * q1) + (q2 * q2 + q3 * q3)), sk = wave_sum(k0 * k0 + k1 * k1);
                    if (lane == 0) { rstdq[t] = rsq_(sq * (1.f / 256.f) + EPS); rstdkv[t] = rsq_(sk * (1.f / 128.f) + EPS); } }
#pragma unroll
                for (int i = 0; i < 4; ++i) xr[i] = xr[8 + i];
            }
#undef CONV_ROW
        }
    }
    SEAM(5);
    if (IN(6)) {
        { pg8::Gemm g{pa, Wuq, M, 768, 256, 512, 256, 0, 0}; pg8::StaticOrder S; S.init(M, 768, G, bx); pg8::EpiStore<CfgQ> E{ws, rstdq, nullptr}; pg8::gemm_phase(lds, g, S, E, wave); }
        { pg8::Gemm g{pa + 256, Wukv, M, 1024, 128, 512, 128, 0, 0}; pg8::StaticOrder S; S.init(M, 1024, G, bx); pg8::EpiStore<CfgKV> E{ws, rstdkv, nullptr}; pg8::gemm_phase(lds, g, S, E, wave); }
        { pg8::Gemm g{xcm, Wm, M, 1536, 256, 1024, 256, 256, 512}; pg8::StaticOrder S; S.init(M, 1536, G, bx); pg8::EpiStore<CfgM> E{ws, nullptr, nullptr}; pg8::gemm_phase(lds, g, S, E, wave); }
    }
    SEAM(6);
    if (IN(7)) { PH_TID();
        const int hh = lane >> 3, sub = lane & 7;
        const float inv0 = powf(10000.f, -(float)(2 * sub) / 16.f), inv1 = powf(10000.f, -(float)(2 * sub + 1) / 16.f);
        float qw[12], kw[12];
#pragma unroll
        for (int e = 0; e < 8; ++e) { qw[e] = args.q_norm_w[8 * sub + e]; kw[e] = args.k_norm_w[8 * sub + e]; }
#pragma unroll
        for (int e = 0; e < 2; ++e) { qw[8 + e] = args.q_norm_w[64 + 2 * sub + e]; qw[10 + e] = args.q_norm_w[80 + 2 * sub + e]; kw[8 + e] = args.k_norm_w[64 + 2 * sub + e]; kw[10 + e] = args.k_norm_w[80 + 2 * sub + e]; }
        const float qscale = 0.10206207261596577f * LOG2E;
        for (int t = gw; t < M; t += NGW) {
            const float pos = (float)args.positions[t];
            float c0, s0, c1, s1;
            { const float C = 0.15915494f, CL = 6.4206383e-09f; const float t0 = pos * inv0, t1 = pos * inv1;
              const float h0 = t0 * C, h1 = t1 * C; const float l0 = __builtin_fmaf(t0, C, -h0) + t0 * CL, l1 = __builtin_fmaf(t1, C, -h1) + t1 * CL;
              const float f0 = (h0 - floorf(h0)) + l0, f1 = (h1 - floorf(h1)) + l1;
              s0 = __builtin_amdgcn_sinf(f0); c0 = __builtin_amdgcn_cosf(f0); s1 = __builtin_amdgcn_sinf(f1); c1 = __builtin_amdgcn_cosf(f1); }
            { bf16_t* base = Qb + (size_t)t * 768 + hh * 96; float v[8]; unpack8(*(const u32x4*)(base + 8 * sub), v);
              const unsigned r1 = *(const unsigned*)(base + 64 + 2 * sub), r2 = *(const unsigned*)(base + 80 + 2 * sub);
              float x1a = __uint_as_float(r1 << 16), x1b_ = __uint_as_float(r1 & 0xffff0000u), x2a = __uint_as_float(r2 << 16), x2b_ = __uint_as_float(r2 & 0xffff0000u);
              float sq = (x1a * x1a + x1b_ * x1b_) + (x2a * x2a + x2b_ * x2b_);
#pragma unroll
              for (int e = 0; e < 8; ++e) sq += v[e] * v[e];
              sq += __shfl_xor(sq, 1); sq += __shfl_xor(sq, 2); sq += __shfl_xor(sq, 4);
              const float rn = rsq_(sq * (1.f / 96.f) + EPS) * qscale;
#pragma unroll
              for (int e = 0; e < 8; ++e) v[e] = v[e] * (rn * 8.f) * qw[e];
              x1a = x1a * rn * qw[8]; x1b_ = x1b_ * rn * qw[9]; x2a = x2a * rn * qw[10]; x2b_ = x2b_ * rn * qw[11];
              *(u32x2*)((char*)base + 8 * sub) = (u32x2){pack4_fp8(v[0], v[1], v[2], v[3]), pack4_fp8(v[4], v[5], v[6], v[7])};
              *(unsigned*)(base + 64 + 2 * sub) = cvt_pk_bf16(x1a * c0 - x2a * s0, x1b_ * c1 - x2b_ * s1);
              *(unsigned*)(base + 80 + 2 * sub) = cvt_pk_bf16(x2a * c0 + x1a * s0, x2b_ * c1 + x1b_ * s1); }
            { bf16_t* base = Kb + (size_t)t * 768 + hh * 96; float v[8]; unpack8(*(const u32x4*)(base + 8 * sub), v);
              const unsigned r1 = *(const unsigned*)(pa + (size_t)t * 512 + 384 + 2 * sub), r2 = *(const unsigned*)(pa + (size_t)t * 512 + 400 + 2 * sub);
              float x1a = __uint_as_float(r1 << 16), x1b_ = __uint_as_float(r1 & 0xffff0000u), x2a = __uint_as_float(r2 << 16), x2b_ = __uint_as_float(r2 & 0xffff0000u);
              float sq = (x1a * x1a + x1b_ * x1b_) + (x2a * x2a + x2b_ * x2b_);
#pragma unroll
              for (int e = 0; e < 8; ++e) sq += v[e] * v[e];
              sq += __shfl_xor(sq, 1); sq += __shfl_xor(sq, 2); sq += __shfl_xor(sq, 4);
              const float rn = rsq_(sq * (1.f / 96.f) + EPS);
#pragma unroll
              for (int e = 0; e < 8; ++e) v[e] = v[e] * rn * kw[e];
              x1a = x1a * rn * kw[8]; x1b_ = x1b_ * rn * kw[9]; x2a = x2a * rn * kw[10]; x2b_ = x2b_ * rn * kw[11];
              *(u32x2*)((char*)base + 8 * sub) = (u32x2){pack4_fp8(v[0], v[1], v[2], v[3]), pack4_fp8(v[4], v[5], v[6], v[7])};
              *(unsigned*)(base + 64 + 2 * sub) = cvt_pk_bf16(x1a * c0 - x2a * s0, x1b_ * c1 - x2b_ * s1);
              *(unsigned*)(base + 80 + 2 * sub) = cvt_pk_bf16(x2a * c0 + x1a * s0, x2b_ * c1 + x1b_ * s1); }
        }
        for (int task = gw; task < 8192; task += NGW) { const int bh = task >> 7, tl = task & 127;
            const bf16_t* vp = Vb + ((size_t)(bh >> 3) * SEQ + (size_t)tl * 64) * 512 + (bh & 7) * 64 + lane; bf16_t vv[64];
#pragma unroll
            for (int k = 0; k < 64; ++k) vv[k] = vp[(size_t)k * 512];
            unsigned char* dst = ws + WS_VT8 + (size_t)task * 4096 + lane * 64;
#pragma unroll
            for (int c = 0; c < 4; ++c) { const int hh = c >> 1, half = c & 1; u32x4 w;
#define VT_W(a) pack4_fp8(bf2f(vv[32 * half + 8 * (a) + 4 * hh]), bf2f(vv[32 * half + 8 * (a) + 4 * hh + 1]), bf2f(vv[32 * half + 8 * (a) + 4 * hh + 2]), bf2f(vv[32 * half + 8 * (a) + 4 * hh + 3]))
                w.x = VT_W(0); w.y = VT_W(1); w.z = VT_W(2); w.w = VT_W(3);
#undef VT_W
                *(u32x4*)(dst + ((c ^ ((lane >> 2) & 3)) << 4)) = w; }
        }
        for (int task = gw; task < 4096; task += NGW) { const int bhd = task >> 6, cs = task & 63, b = bhd >> 3, h = (bhd >> 1) & 3, dir = bhd & 1;
            ml::gate_scan(gatesb, b, h, dir, cs, args.b_igate[dir * 4 + h], args.b_fgate[dir * 4 + h], (float*)(ws + WS_GSC) + (size_t)task * 384, (float*)(ws + WS_GSC) + (size_t)4096 * 384 + task * 2, lane); }
    }
    SEAM(7);
    if (IN(8)) {
#define ATT_UNIT(bh_, qb_) do { const int b_ = (bh_) >> 3, h_ = (bh_) & 7; const size_t row0 = (size_t)b_ * SEQ; \
            if (nomax) att::attn_unit2<true>(Qb + (row0 + (size_t)(qb_) * 256) * 768 + h_ * 96, Kb + row0 * 768 + h_ * 96, ws + WS_VT8 + (size_t)(bh_) * (128 * 4096), xcm + (row0 + (size_t)(qb_) * 256) * 1024 + 512 + h_ * 64, SEQ, (char*)lds_raw, wave); \
            else att::attn_unit2<false>(Qb + (row0 + (size_t)(qb_) * 256) * 768 + h_ * 96, Kb + row0 * 768 + h_ * 96, ws + WS_VT8 + (size_t)(bh_) * (128 * 4096), xcm + (row0 + (size_t)(qb_) * 256) * 1024 + 512 + h_ * 64, SEQ, (char*)lds_raw, wave); } while (0)
#define CHAIN_UNIT(u_) do { const int dir = (u_) & 1, sl = ((u_) >> 1) & 1, h = ((u_) >> 2) & 3, b = (u_) >> 4; \
            const int bhd = (b * 4 + h) * 2 + dir; ml::chain(lds, b, h, sl, dir, mqkv, dir ? hbb : hfb, (const float*)(ws + WS_GSC) + (size_t)bhd * (64 * 384), (const float*)(ws + WS_GSC) + (size_t)4096 * 384 + bhd * 128, wave); \
            asm volatile("s_waitcnt vmcnt(0)" ::: "memory"); __syncthreads(); \
            if (wave == 0 && lane_id() == 0) { __builtin_amdgcn_fence(__ATOMIC_RELEASE, "agent"); asm volatile("s_waitcnt vmcnt(0)" ::: "memory"); (void)xb_add(ctl + CW_CHAINS, 1u); }   \
            } while (0)
        bool nomax; { const int l_ = lane_id(); float wq = 0.f, wk = 0.f;
            for (int e = l_; e < 96; e += 64) { wq = fmaxf(wq, fabsf(args.q_norm_w[e])); wk = fmaxf(wk, fabsf(args.k_norm_w[e])); }
#pragma unroll
            for (int o = 1; o < 64; o <<= 1) { wq = fmaxf(wq, __shfl_xor(wq, o)); wk = fmaxf(wk, __shfl_xor(wk, o)); }
            const float bound = 9.797959f * 1.02f * LOG2E * wq * wk;
            nomax = __builtin_amdgcn_readfirstlane((int)(bound <= 19.5f)) != 0; }
        const bool fast = (G == 256); const int x = vcu >> 5, j = vcu & 31; const bool chainwg = fast ? ((j & 1) == 0) : true;
        for (int u = fast ? (chainwg ? (vcu >> 1) : 128) : vcu; u < 128; u += (fast ? 128 : G)) CHAIN_UNIT(u);
        const int nit = fast ? (chainwg ? 7 : 9) : (2048 - vcu + G - 1) / G;
        for (int it = 0; it < nit; ++it) { int bh, qb;
            if (fast) { const int s = it + (chainwg ? 2 : 0); if (s < 2) { bh = x; qb = 16 * s + (j >> 1); } else { bh = 8 * (s - 1) + x; qb = j; } }
            else { const int u = vcu + it * G; bh = u >> 5; qb = u & 31; }
            ATT_UNIT(bh, qb); }
#undef ATT_UNIT
#undef CHAIN_UNIT
        { pg8::Gemm g{(const bf16_t*)args.out, Wgab, M, 2048, DM / 2, DM / 2, DM / 2, 0, 0}; pg8::StaticOrder S; S.init(M, 2048, G, bx);
          if (fast) { S.n_all = 5; S.hv = chainwg ? -1 : (vcu >> 1); }
          pg8::EpiSig E{sig0_, sig1_, rstd1, 1.f / 32.f};
          pg8::gemm_phase<pg8::EpiSig, true>(lds, g, S, E, wave); }

        __syncthreads();
        if (wave == 0 && lane_id() == 0) { XB_SPIN(xb_ld(ctl + CW_CHAINS) < 128u, ctl + CW_BAR); __builtin_amdgcn_fence(__ATOMIC_ACQUIRE, "agent"); asm volatile("s_waitcnt vmcnt(0)" ::: "memory"); }
        __syncthreads();
        { PH_TID();
        float nw[8], sk[8];
#pragma unroll
        for (int e = 0; e < 8; ++e) { nw[e] = args.m_norm_w[8 * lane + e]; sk[e] = args.m_skip[8 * lane + e]; }
        for (int t4 = gw * 4; t4 < M; t4 += NGW * 4) {
            u32x4 ra[4], rb[4], ro[4], rx[4];
#pragma unroll
            for (int u = 0; u < 4; ++u) { const size_t t = (size_t)(t4 + u);
                ra[u] = *(const u32x4*)(hfb + t * 512 + 8 * lane); rb[u] = *(const u32x4*)(hbb + t * 512 + 8 * lane);
                ro[u] = *(const u32x4*)(opre + t * 512 + 8 * lane); rx[u] = *(const u32x4*)(xcm + t * 1024 + 8 * lane); }
#pragma unroll
            for (int u = 0; u < 4; ++u) { float a[8], b[8], o[8], xv[8]; unpack8(ra[u], a); unpack8(rb[u], b); unpack8(ro[u], o); unpack8(rx[u], xv);
                float sq = 0.f;
#pragma unroll
                for (int e = 0; e < 8; ++e) { a[e] += b[e]; sq += a[e] * a[e]; }
#define SHX_(v, m) __int_as_float(__builtin_amdgcn_ds_bpermute((lane ^ (m)) << 2, __float_as_int(v)))
                sq += SHX_(sq, 1); sq += SHX_(sq, 2); sq += SHX_(sq, 4); sq += SHX_(sq, 8);
#undef SHX_
                const float rn = rsq_(sq * (1.f / 128.f) + EPS);
#pragma unroll
                for (int e = 0; e < 8; ++e) a[e] = sigmoidf_(o[e]) * (a[e] * rn * nw[e] + sk[e] * xv[e]);
                *(u32x4*)(xcm + (size_t)(t4 + u) * 1024 + 8 * lane) = pack8(a); }
        }
    }
    }
    SEAM(8);
#if defined(ATT_SELFCHECK)
    if (IN(8)) { PH_TID();
        for (int smp = gw; smp < 4096; smp += NGW) {
            const int b = smp & 7, h = (smp >> 3) & 7, r = (((smp >> 6) * 129) + (smp & 63) * 1031 + (smp >> 6) * 4) & 8191;
            const size_t row = (size_t)b * SEQ + r;
            const bf16_t* qp = Qb + row * 768 + h * 96;
            float l = 0.f, acc[64];
#pragma unroll
            for (int e = 0; e < 64; ++e) acc[e] = 0.f;
            for (int kk = lane; kk < SEQ; kk += 64) {
                const bf16_t* kp = Kb + ((size_t)b * SEQ + kk) * 768 + h * 96; float sc_ = 0.f;
#pragma unroll
                for (int c = 0; c < 16; ++c) { const int qw_ = ((const int*)qp)[c], kw_ = ((const int*)kp)[c];
                    sc_ += 0.125f * (__builtin_amdgcn_cvt_f32_fp8(qw_, 0) * __builtin_amdgcn_cvt_f32_fp8(kw_, 0) + __builtin_amdgcn_cvt_f32_fp8(qw_, 1) * __builtin_amdgcn_cvt_f32_fp8(kw_, 1)
                                     + __builtin_amdgcn_cvt_f32_fp8(qw_, 2) * __builtin_amdgcn_cvt_f32_fp8(kw_, 2) + __builtin_amdgcn_cvt_f32_fp8(qw_, 3) * __builtin_amdgcn_cvt_f32_fp8(kw_, 3)); }
#pragma unroll
                for (int c = 8; c < 12; ++c) { float qf[8], kf[8]; unpack8(*(const u32x4*)(qp + 8 * c), qf); unpack8(*(const u32x4*)(kp + 8 * c), kf);
#pragma unroll
                    for (int e = 0; e < 8; ++e) sc_ += qf[e] * kf[e]; }
                const float p = exp2f(sc_ + att::POFF), pq = __builtin_amdgcn_cvt_f32_bf8(__builtin_amdgcn_cvt_pk_bf8_f32(p, p, 0, false), 0); l += p;
                { const int kin = kk & 63, half = kin >> 5, hh = (kin >> 2) & 1, a_ = (kin & 31) >> 3, ii = kin & 3, c = 2 * hh + half;
                  const unsigned char* vt = ws + WS_VT8 + ((size_t)((b * 8 + h) * 128 + (kk >> 6))) * 4096 + 4 * a_ + ii;
#pragma unroll
                  for (int d = 0; d < 64; ++d) acc[d] += pq * __builtin_amdgcn_cvt_f32_fp8((int)vt[d * 64 + ((c ^ ((d >> 2) & 3)) << 4)], 0); }
            }
            const float fs = 1.f; l = wave_sum(l);
            const bf16_t* ap = xcm + row * 1024 + 512 + h * 64; float err = 0.f, scl = 0.f;
#pragma unroll
            for (int e = 0; e < 64; ++e) { const float ref = wave_sum(acc[e] * fs) / l, got = bf2f(ap[e]); err = fmaxf(err, fabsf(got - ref)); scl = fmaxf(scl, fabsf(ref)); }
            if (lane == 0 && !(err <= (float)(ATT_SELFCHECK) * scl)) atomicAdd(ctl + CW_BAR + XB_TMO, 1u);
        }
    }
    if (IN(8) && IN(9)) xcd_barrier(bar, wave);
#endif
    if (IN(11)) { pg8::Gemm g{xcm, Wa, M, DM, DM, DM, DM, 0, 0}; pg8::StaticOrder S; S.init(M, DM, G, bx); pg8::EpiMerge E{merged, sig0_, sig1_}; pg8::gemm_phase(lds, g, S, E, wave); }
    SEAM(11);
    if (IN(12)) { pg8::Gemm g{merged, Wout, M, DM, DM, DM, DM, 0, 0}; pg8::StaticOrder S; S.init(M, DM, G, bx); pg8::EpiRes<false> E{x1b, x2b, rstd2, 1.0f, nullptr}; pg8::gemm_phase(lds, g, S, E, wave); }
    SEAM(12);
    if (IN(14)) { pg8::Gemm g{x2b, Wgu2, M, NGU, DM, DM, DM, 0, 0}; pg8::StaticOrder S; S.init(M, NGU, G, bx); pg8::EpiSwiglu E{act, rstd2}; pg8::gemm_phase(lds, g, S, E, wave); }
    SEAM(14);
    if (IN(15)) { pg8::Gemm g{act, Wd2, M, DM, FFN, FFN, FFN, 0, 0}; pg8::StaticOrder S; S.init(M, DM, G, bx); pg8::EpiRes<false> E{x2b, x1b  , ss3, 0.5f, nullptr}; pg8::gemm_phase(lds, g, S, E, wave); }
    SEAM(15);
    if (IN(16)) { PH_TID();
        f32x4 fw[4];
#pragma unroll
        for (int j = 0; j < 4; ++j) fw[j] = ((const f32x4*)args.final_norm_w)[4 * lane + j];
        const bool poison = __hip_atomic_load(ctl + CW_BAR + XB_TMO, __ATOMIC_RELAXED, __HIP_MEMORY_SCOPE_AGENT) != 0u;
        for (int m8 = gw * 8; m8 < M; m8 += NGW * 8) {
            u32x4 v[8][2]; float sv[8];
#pragma unroll
            for (int u = 0; u < 8; ++u) { const u32x4* xr = (const u32x4*)(x1b + (size_t)(m8 + u) * DM + 16 * lane); v[u][0] = xr[0]; v[u][1] = xr[1]; sv[u] = ss3[m8 + u]; }
#pragma unroll
            for (int u = 0; u < 8; ++u) { const float rn = poison ? __builtin_nanf("") : rsq_(sv[u] * (1.f / DM) + EPS);
                float a[8], b[8]; unpack8(v[u][0], a); unpack8(v[u][1], b);
                f32x4* orow = (f32x4*)(args.out + (size_t)(m8 + u) * DM + 16 * lane);
                orow[0] = (f32x4){a[0], a[1], a[2], a[3]} * rn * fw[0]; orow[1] = (f32x4){a[4], a[5], a[6], a[7]} * rn * fw[1];
                orow[2] = (f32x4){b[0], b[1], b[2], b[3]} * rn * fw[2]; orow[3] = (f32x4){b[4], b[5], b[6], b[7]} * rn * fw[3]; }
        }
    }
#if defined(DBG_STOP)
    if (lo <= 99 && 99 < hi) { PH_TID();
        const bf16_t* src16 = (const bf16_t*)(ws + (size_t)DBG_LO * MiB); const size_t n16 = ((size_t)(DBG_HI - DBG_LO) * MiB) / 2, NOUT = (size_t)M * DM;
        for (size_t e = (size_t)bx * 512 + tid; e < NOUT; e += (size_t)G * 512) { float s = 0.f; for (size_t j = e; j < n16; j += NOUT) s += bf2f(src16[j]); args.out[e] = s; }
    }
#endif
#undef IN
#undef SEAM
}

extern "C" void kernel_launch(void* const* d_in, const int* in_sizes, int n_in, void* d_out, int out_size, void* d_ws, size_t ws_size, hipStream_t stream) {
    static int grid = 0;
    if (grid == 0) {
        if (n_in != 32 || in_sizes[0] != M * DM || out_size != M * DM || ws_size < WS_END) {
            fprintf(stderr, "kernel_launch: built for 32 inputs, x/out of %d floats, >= %zu bytes of workspace; got n_in %d, in0 %d, out %d, ws %zu\n", M * DM, (size_t)WS_END, n_in, n_in > 0 ? in_sizes[0] : -1, out_size, ws_size);
            grid = -1; return; }
        int dev = 0, cus = 0, per_cu = 0;
        if (hipGetDevice(&dev) != hipSuccess || hipDeviceGetAttribute(&cus, hipDeviceAttributeMultiprocessorCount, dev) != hipSuccess) { grid = -1; return; }
        if (hipFuncSetAttribute((const void*)fwd_kernel, hipFuncAttributeMaxDynamicSharedMemorySize, LDS_BYTES) != hipSuccess) { fprintf(stderr, "kernel_launch: hipFuncSetAttribute failed\n"); grid = -1; return; }
        if (hipOccupancyMaxActiveBlocksPerMultiprocessor(&per_cu, (const void*)fwd_kernel, 512, LDS_BYTES) != hipSuccess || per_cu < 1)
            fprintf(stderr, "kernel_launch: note: occupancy query reports %d workgroups per CU\n", per_cu);
        (void)hipGetLastError();
        grid = cus;
    }
    if (grid < 0) return;
    (void)hipMemsetAsync((char*)d_ws + WS_CTL, 0, CTL_ZERO_BYTES, stream);
    Args a{};
    a.x = (const float*)d_in[0]; a.positions = (const int*)d_in[1];
    const float** fp = &a.ffn1_norm_w;
    for (int i = 0; i < 30; ++i) fp[i] = (const float*)d_in[2 + i];
    a.out = (float*)d_out; a.ws = (unsigned char*)d_ws;
#ifndef MK_PER_PHASE
#define MK_PER_PHASE 0
#endif
#if defined(DBG_STOP)
    for (int p = 0; p <= DBG_STOP; ++p) { a.ph_lo = p; a.ph_hi = p + 1; hipLaunchKernelGGL(fwd_kernel, dim3(grid), dim3(512), LDS_BYTES, stream, a); }
    a.ph_lo = 99; a.ph_hi = 100; hipLaunchKernelGGL(fwd_kernel, dim3(grid), dim3(512), LDS_BYTES, stream, a);
    return;
#endif
    if (MK_PER_PHASE) { for (int p = 0; p < NPHASE - 1; ++p) { a.ph_lo = p; a.ph_hi = p + 1; hipLaunchKernelGGL(fwd_kernel, dim3(grid), dim3(512), LDS_BYTES, stream, a); } }
    else { a.ph_lo = 0; a.ph_hi = NPHASE; hipLaunchKernelGGL(fwd_kernel, dim3(grid), dim3(512), LDS_BYTES, stream, a); }
    const hipError_t le = hipPeekAtLastError();
    if (le != hipSuccess) fprintf(stderr, "kernel_launch: launch failed: %s\n", hipGetErrorName(le));
}
```

```cpp
#include <hip/hip_runtime.h>
#include <cstdio>
#include <cstdint>

#define LAS __attribute__((address_space(3)))
#define GAS __attribute__((address_space(1)))
typedef unsigned short bf16_t;
typedef short bf16x8 __attribute__((ext_vector_type(8)));
typedef short s16x4 __attribute__((ext_vector_type(4)));
typedef float f32x4 __attribute__((ext_vector_type(4)));
typedef float f32x2 __attribute__((ext_vector_type(2)));
typedef float f32x16 __attribute__((ext_vector_type(16)));
typedef unsigned u32x4 __attribute__((ext_vector_type(4)));
typedef unsigned u32x2 __attribute__((ext_vector_type(2)));
typedef int i32x8 __attribute__((ext_vector_type(8)));
typedef int i32x4_t __attribute__((ext_vector_type(4)));

constexpr int BATCH = 8, SEQ = 8192, DM = 1024, M = BATCH * SEQ;
constexpr int FFN = 2816, NGU = 2 * FFN;
constexpr int IN_DIM = 3504;
constexpr float EPS = 1e-6f;
constexpr float LOG2E = 1.4426950408889634f;

typedef __bf16 bf16x2_t __attribute__((ext_vector_type(2)));
__device__ __forceinline__ unsigned cvt_pk_bf16(float lo, float hi) { f32x2 v = {lo, hi}; bf16x2_t b = __builtin_convertvector(v, bf16x2_t); return __builtin_bit_cast(unsigned, b); }
__device__ __forceinline__ bf16_t f2bf(float f) { return (bf16_t)(cvt_pk_bf16(f, 0.f) & 0xffffu); }
__device__ __forceinline__ float bf2f(bf16_t b) { return __uint_as_float((unsigned)b << 16); }
__device__ __forceinline__ void unpack8(const u32x4 w, float (&f)[8]) {
    f[0] = __uint_as_float(w.x << 16); f[1] = __uint_as_float(w.x & 0xffff0000u);
    f[2] = __uint_as_float(w.y << 16); f[3] = __uint_as_float(w.y & 0xffff0000u);
    f[4] = __uint_as_float(w.z << 16); f[5] = __uint_as_float(w.z & 0xffff0000u);
    f[6] = __uint_as_float(w.w << 16); f[7] = __uint_as_float(w.w & 0xffff0000u);
}
__device__ __forceinline__ u32x4 pack8(const float (&f)[8]) {
    u32x4 w; w.x = cvt_pk_bf16(f[0], f[1]); w.y = cvt_pk_bf16(f[2], f[3]); w.z = cvt_pk_bf16(f[4], f[5]); w.w = cvt_pk_bf16(f[6], f[7]); return w;
}
__device__ __forceinline__ unsigned pack4_fp8(float a, float b, float c, float d) { int w = 0; w = __builtin_amdgcn_cvt_pk_fp8_f32(a, b, w, false); w = __builtin_amdgcn_cvt_pk_fp8_f32(c, d, w, true); return (unsigned)w; }
__device__ __forceinline__ unsigned pack4_bf8(float a, float b, float c, float d) { int w = 0; w = __builtin_amdgcn_cvt_pk_bf8_f32(a, b, w, false); w = __builtin_amdgcn_cvt_pk_bf8_f32(c, d, w, true); return (unsigned)w; }
__device__ __forceinline__ float rsq_(float x) { return __builtin_amdgcn_rsqf(x); }
__device__ __forceinline__ float sigmoidf_(float x) { return __builtin_amdgcn_rcpf(1.f + __expf(-x)); }
__device__ __forceinline__ int lane_id() { unsigned z = 0u; asm volatile("" : "+v"(z)); return (int)__builtin_amdgcn_mbcnt_hi(~0u, __builtin_amdgcn_mbcnt_lo(~0u, z)); }
__device__ __forceinline__ float wave_sum(float v) {
#pragma unroll
    for (int o = 1; o < 64; o <<= 1) v += __shfl_xor(v, o);
    return v;
}

namespace pg8 {
constexpr int BM = 256, BK = 64, HALF = 128, HTB = HALF * BK * 2, STAGE_BYTES = 8 * HTB, NXCD = 8, WGM = 8;
__host__ __device__ __forceinline__ int lds_byte(int r, int c) { const int st = (r >> 4) * 2 + (c >> 5), rr = r & 15, cc = c & 31, ob = rr * 64 + cc * 2; return st * 1024 + (ob ^ (((ob >> 9) & 1) << 5)); }
__host__ __device__ __forceinline__ void stage_rc(int b, int& R, int& C) { const int st = b / 1024, sb = b % 1024, swz = sb ^ (((sb >> 9) & 1) << 5); R = (st >> 1) * 16 + swz / 64; C = (st & 1) * 32 + (swz % 64) / 2; }
__host__ __device__ __forceinline__ int perm32(int rho) { const int n = rho >> 4, i = rho & 15; return 8 * (i >> 2) + 4 * n + (i & 3); }

struct Unit { int pm, pn; };
template <bool F8> struct Frag;
template <> struct Frag<false> { bf16x8 v[2]; };
template <> struct Frag<true> { i32x8 w; };
struct Gemm { const bf16_t* A; const bf16_t* Bt; int M, N, K, lda, ldb, ao1, ao2; };

struct StaticOrder {
    int nM, nN, nwg, G, c, n_all, hv, nh;
    __host__ __device__ void init(int M_, int N_, int G_, int c_) { nM = M_ / BM; nN = N_ / BM; nwg = nM * nN; G = G_; c = c_; n_all = -1; hv = -1; nh = G_ / 2; }
    __host__ __device__ bool next(int i, Unit& u) const {
        long L = (long)i * G + c;
        if (n_all >= 0 && i >= n_all) { if (hv < 0) return false; L = (long)n_all * G + (long)(i - n_all) * nh + hv; }
        if (L >= nwg) return false;
        int wgid = (int)L; { const int q = nwg / NXCD, r = nwg % NXCD, xcd = wgid % NXCD, off = wgid / NXCD; wgid = (xcd < r ? xcd * (q + 1) : r * (q + 1) + (xcd - r) * q) + off; }
        const int nig = WGM * nN, gid = wgid / nig, fm = gid * WGM, gsz = (nM - fm) < WGM ? (nM - fm) : WGM;
        u.pm = fm + ((wgid % nig) % gsz); u.pn = (wgid % nig) / gsz; return true;
    }
};

template <class Epi, bool F8 = false>
__device__ __forceinline__ void gemm_phase(LAS unsigned char* lds, const Gemm g, const StaticOrder& S, const Epi& E, const int wv) {
    int lane = lane_id(); asm volatile("" : "+v"(lane));
    const int wid = wv, tid = wv * 64 + lane, wr = wid >> 2, wc = wid & 3, fr = lane & 15, fq = lane >> 4;
    const int K = g.K; int nt = K / BK; if constexpr (F8) asm volatile("" : "+s"(nt));
    unsigned voffA[2], voffB[2];
#pragma unroll
    for (int i = 0; i < 2; ++i) { int R, C; stage_rc(tid * 16 + i * 8192, R, C); const int Rb = (R & ~31) + perm32(R & 31);
        voffA[i] = (unsigned)(R * g.lda + C) * 2u; voffB[i] = (unsigned)(Rb * g.ldb + C) * 2u; }
    const size_t kstep = (size_t)(BK * 2);
    const size_t hstepA = (size_t)HALF * g.lda * 2, hstepB = (size_t)HALF * g.ldb * 2;
    const size_t tstepA = 2 * hstepA, tstepB = 2 * hstepB;
    const unsigned ldsw = (unsigned)wid * 1024u;
    const int aoff = lds_byte(wr * 64 + fr, fq * 8), boff = lds_byte(wc * 32 + fr, fq * 8);
#define PG8_SA(b, h) (((b) * 2 + (h)) * HTB)
#define PG8_SB(b, h) ((4 + (b) * 2 + (h)) * HTB)
#define PG8_STAGE(bufoff, gbase, voff) do { _Pragma("unroll") for (int _i = 0; _i < 2; ++_i) { \
        unsigned keep_; const unsigned dst_ = (unsigned)(__UINTPTR_TYPE__)(lds + (bufoff) + ldsw + _i * 8192);        \
        asm volatile("s_mov_b32 %0, m0\n\ts_mov_b32 m0, %3\n\ts_nop 0\n\tglobal_load_lds_dwordx4 %1, %2\n\ts_mov_b32 m0, %0" : "=&s"(keep_) : "v"((voff)[_i]), "s"((const char*)(gbase)), "s"(dst_) : "memory"); } } while (0)
#define PG8_LD1(dst, base) do { if constexpr (F8) { const i32x4_t lo_ = *(const LAS i32x4_t*)(base), hi_ = *(const LAS i32x4_t*)((base) + 1024); dst.w = __builtin_shufflevector(lo_, hi_, 0, 1, 2, 3, 4, 5, 6, 7); } \
        else { dst.v[0] = *(const LAS bf16x8*)(base); dst.v[1] = *(const LAS bf16x8*)((base) + 1024); } } while (0)
#define PG8_LDA(dst, b, h) do { _Pragma("unroll") for (int m = 0; m < 4; ++m) PG8_LD1(dst[m], lds + PG8_SA(b, h) + aoff + m * 2048); } while (0)
#define PG8_LDB(dst, b, h) do { _Pragma("unroll") for (int n = 0; n < 2; ++n) PG8_LD1(dst[n], lds + PG8_SB(b, h) + boff + n * 2048); } while (0)
#define PG8_MMA(ai, bj, At, Bt) do { __builtin_amdgcn_s_setprio(1); \
        if constexpr (F8) { _Pragma("unroll") for (int m = 0; m < 4; ++m) _Pragma("unroll") for (int n = 0; n < 2; ++n) \
            acc[ai][bj][m][n] = __builtin_amdgcn_mfma_scale_f32_16x16x128_f8f6f4(Bt[n].w, At[m].w, acc[ai][bj][m][n], 0, 0, 0, 0, 0, 0); } \
        else { _Pragma("unroll") for (int m = 0; m < 4; ++m) _Pragma("unroll") for (int n = 0; n < 2; ++n) _Pragma("unroll") for (int k = 0; k < 2; ++k) \
            acc[ai][bj][m][n] = __builtin_amdgcn_mfma_f32_16x16x32_bf16(Bt[n].v[k], At[m].v[k], acc[ai][bj][m][n], 0, 0, 0); } \
        __builtin_amdgcn_s_setprio(0); } while (0)
#define PG8_WAIT_V(n) asm volatile("s_waitcnt vmcnt(" #n ")" ::: "memory")
#define PG8_WAIT_L(n) asm volatile("s_waitcnt lgkmcnt(" #n ")" ::: "memory")
#define PG8_BAR __builtin_amdgcn_s_barrier()
#define PG8_SCHED __builtin_amdgcn_sched_barrier(0)
#define PG8_AOFF(u) ((size_t)(((u).pn & 1) * g.ao1 + ((u).pn >> 2) * g.ao2) * 2)
    Unit cur, nxt; int ui = 0;
    if (!S.next(0, cur)) return;
    f32x4 acc[2][2][4][2];
#pragma unroll
    for (int a = 0; a < 2; ++a)
#pragma unroll
        for (int b = 0; b < 2; ++b)
#pragma unroll
            for (int m = 0; m < 4; ++m)
#pragma unroll
                for (int n = 0; n < 2; ++n) acc[a][b][m][n] = (f32x4){0.f, 0.f, 0.f, 0.f};
    Frag<F8> At[4], B0[2], B1[2];
    const char* cA = (const char*)g.A + (size_t)cur.pm * tstepA + PG8_AOFF(cur); const char* cB = (const char*)g.Bt + (size_t)cur.pn * tstepB;
    PG8_STAGE(PG8_SB(0, 0), cB, voffB); PG8_STAGE(PG8_SB(0, 1), cB + hstepB, voffB); PG8_STAGE(PG8_SA(0, 0), cA, voffA); PG8_STAGE(PG8_SA(0, 1), cA + hstepA, voffA);
    if (wr == 1) PG8_BAR;
    PG8_WAIT_V(2); PG8_BAR;
    PG8_STAGE(PG8_SB(1, 0), cB + kstep, voffB); PG8_STAGE(PG8_SA(1, 0), cA + kstep, voffA); PG8_STAGE(PG8_SB(1, 1), cB + hstepB + kstep, voffB);
    PG8_WAIT_V(6); PG8_BAR;
    for (;;) {
        const bool has_next = S.next(ui + 1, nxt);
        const char* nA = has_next ? (const char*)g.A + (size_t)nxt.pm * tstepA + PG8_AOFF(nxt) : cA; const char* nB = has_next ? (const char*)g.Bt + (size_t)nxt.pn * tstepB : cB;
        for (int t = 0; t < nt; t += 2) {
            if constexpr (Epi::MIDK) { if (t == (nt >> 1)) { const int l2 = lane_id(); E.mid(acc, cur, wr, wc, l2 & 15, l2 >> 4); } }
            const bool last = (t == nt - 2);
            const char* a1 = cA + (size_t)(t + 1) * kstep;
            const char* a2 = last ? nA : cA + (size_t)(t + 2) * kstep; const char* b2 = last ? nB : cB + (size_t)(t + 2) * kstep;
            const char* a3 = a2 + kstep; const char* b3 = b2 + kstep;
            PG8_LDB(B0, 0, 0); PG8_LDB(B1, 0, 1); PG8_SCHED; PG8_LDA(At, 0, 0); PG8_STAGE(PG8_SA(1, 1), a1 + hstepA, voffA);
            PG8_WAIT_V(8); PG8_WAIT_L(0); PG8_BAR; PG8_MMA(0, 0, At, B0); PG8_MMA(0, 1, At, B1);
            if (t == 0) {
#pragma unroll
                for (int b = 0; b < 2; ++b)
#pragma unroll
                    for (int m = 0; m < 4; ++m)
#pragma unroll
                        for (int n = 0; n < 2; ++n) acc[1][b][m][n] = (f32x4){0.f, 0.f, 0.f, 0.f};
            }
            PG8_BAR; PG8_SCHED;
            PG8_LDA(At, 0, 1); PG8_STAGE(PG8_SB(0, 0), b2, voffB); PG8_STAGE(PG8_SB(0, 1), b2 + hstepB, voffB); PG8_STAGE(PG8_SA(0, 0), a2, voffA);
            PG8_WAIT_V(8); PG8_WAIT_L(0); PG8_BAR; PG8_MMA(1, 0, At, B0); PG8_MMA(1, 1, At, B1); PG8_BAR; PG8_SCHED;
            PG8_LDB(B0, 1, 0); PG8_LDB(B1, 1, 1); PG8_SCHED; PG8_LDA(At, 1, 0); PG8_STAGE(PG8_SA(0, 1), a2 + hstepA, voffA);
            PG8_WAIT_V(8); PG8_WAIT_L(0); PG8_BAR; PG8_MMA(0, 0, At, B0); PG8_MMA(0, 1, At, B1); PG8_BAR; PG8_SCHED;
            PG8_LDA(At, 1, 1); PG8_STAGE(PG8_SB(1, 0), b3, voffB); PG8_STAGE(PG8_SB(1, 1), b3 + hstepB, voffB); PG8_STAGE(PG8_SA(1, 0), a3, voffA);
            PG8_WAIT_V(8); PG8_WAIT_L(0); PG8_BAR; PG8_MMA(1, 0, At, B0); PG8_MMA(1, 1, At, B1); PG8_BAR; PG8_SCHED;
        }
        if (wr == 0) PG8_BAR;
        { const int l2 = lane_id(); E(acc, cur, wr, wc, l2 & 15, l2 >> 4); }
        if (!has_next) break;
#pragma unroll
        for (int b = 0; b < 2; ++b)
#pragma unroll
            for (int m = 0; m < 4; ++m)
#pragma unroll
                for (int n = 0; n < 2; ++n) acc[0][b][m][n] = (f32x4){0.f, 0.f, 0.f, 0.f};
        cur = nxt; cA = nA; cB = nB; ++ui;
        if (wr == 1) PG8_BAR;
    }
    PG8_WAIT_V(0);
    PG8_BAR;
#undef PG8_SA
#undef PG8_SB
#undef PG8_STAGE
#undef PG8_LDA
#undef PG8_LDB
#undef PG8_MMA
#undef PG8_LD1
#undef PG8_WAIT_V
#undef PG8_WAIT_L
#undef PG8_BAR
#undef PG8_SCHED
#undef PG8_AOFF
}

#define EPI_ROWS(ai, m) (u.pm * BM + (ai) * HALF + wr * 64 + (m) * 16 + fr)
#define SSQ_RSTD(v) rsq_((v) * (1.f / DM) + EPS)
struct EpiSwiglu {
    static constexpr bool MIDK = false;
    bf16_t* O; const float* rstd;
    __device__ __forceinline__ void operator()(const f32x4 (&acc)[2][2][4][2], const Unit& u, int wr, int wc, int fr, int fq) const {
        const int col0 = u.pn * HALF + wc * 32 + 8 * fq; float rsv[2][4];
#pragma unroll
        for (int ai = 0; ai < 2; ++ai)
#pragma unroll
            for (int m = 0; m < 4; ++m) rsv[ai][m] = rstd[EPI_ROWS(ai, m)];
#pragma unroll
        for (int ai = 0; ai < 2; ++ai)
#pragma unroll
            for (int m = 0; m < 4; ++m) { const int row = EPI_ROWS(ai, m); const float a_ = rsv[ai][m] * (1.f / DM) + EPS, c1 = -LOG2E * rsq_(a_); float o[8];
#pragma unroll
                for (int n = 0; n < 2; ++n)
#pragma unroll
                    for (int j = 0; j < 4; ++j) { const float g_ = acc[ai][0][m][n][j], e_ = __builtin_amdgcn_exp2f(g_ * c1); o[4 * n + j] = (g_ * acc[ai][1][m][n][j]) * __builtin_amdgcn_rcpf(__builtin_fmaf(e_, a_, a_)); }
                *(u32x4*)(O + (size_t)row * FFN + col0) = pack8(o); }
    }
};
template <bool OUT_F32, bool OUT_F8 = false> struct EpiRes {
    static constexpr bool MIDK = false;
    const bf16_t* res; void* out; float* ss; float alpha; unsigned char* out8;
    __device__ __forceinline__ void operator()(const f32x4 (&acc)[2][2][4][2], const Unit& u, int wr, int wc, int fr, int fq) const {
        u32x4 rv[2][4][2];
#pragma unroll
        for (int ai = 0; ai < 2; ++ai)
#pragma unroll
            for (int m = 0; m < 4; ++m)
#pragma unroll
                for (int bj = 0; bj < 2; ++bj) rv[ai][m][bj] = *(const u32x4*)(res + (size_t)EPI_ROWS(ai, m) * DM + u.pn * BM + bj * HALF + wc * 32 + 8 * fq);
#pragma unroll
        for (int ai = 0; ai < 2; ++ai) {
#pragma unroll
            for (int m = 0; m < 4; ++m) { const int row = EPI_ROWS(ai, m); float sq = 0.f;
#pragma unroll
                for (int bj = 0; bj < 2; ++bj) { const size_t off = (size_t)row * DM + u.pn * BM + bj * HALF + wc * 32 + 8 * fq; float r[8]; unpack8(rv[ai][m][bj], r);
#pragma unroll
                    for (int n = 0; n < 2; ++n)
#pragma unroll
                        for (int j = 0; j < 4; ++j) { const float v = r[4 * n + j] + alpha * acc[ai][bj][m][n][j]; r[4 * n + j] = v; sq += v * v; }
                    if (OUT_F32) { *(f32x4*)((float*)out + off) = (f32x4){r[0], r[1], r[2], r[3]}; *(f32x4*)((float*)out + off + 4) = (f32x4){r[4], r[5], r[6], r[7]}; }
                    else *(u32x4*)((bf16_t*)out + off) = pack8(r);
                    if (OUT_F8) *(u32x2*)(out8 + off) = (u32x2){pack4_fp8(r[0], r[1], r[2], r[3]), pack4_fp8(r[4], r[5], r[6], r[7])}; }
                sq += __shfl_xor(sq, 16); sq += __shfl_xor(sq, 32);
                if (fq == 0) (void)__hip_atomic_fetch_add(ss + row, sq, __ATOMIC_RELAXED, __HIP_MEMORY_SCOPE_AGENT); } }
    }
};
template <class CFG> struct EpiStore {
    static constexpr bool MIDK = false;
    unsigned char* ws; const float* rowscale; float* gates;
    __device__ __forceinline__ void operator()(const f32x4 (&acc)[2][2][4][2], const Unit& u, int wr, int wc, int fr, int fq) const {
        const int grp = u.pn >> 1; const size_t boff = grp == 0 ? CFG::off0 : (grp == 1 ? CFG::off1 : CFG::off2); const int ld = grp == 0 ? CFG::ld0 : (grp == 1 ? CFG::ld1 : CFG::ld2);
        const int cb = (grp == 0 ? CFG::c0 : (grp == 1 ? CFG::c1 : CFG::c2)) + (u.pn & 1) * BM; const bool hp = (grp == 0) && CFG::HP;
        bf16_t* base = (bf16_t*)(ws + boff); float rsv[2][4];
#pragma unroll
        for (int ai = 0; ai < 2; ++ai)
#pragma unroll
            for (int m = 0; m < 4; ++m) rsv[ai][m] = CFG::RS ? rowscale[EPI_ROWS(ai, m)] : 1.f;
#pragma unroll
        for (int ai = 0; ai < 2; ++ai)
#pragma unroll
            for (int m = 0; m < 4; ++m) { const int row = EPI_ROWS(ai, m); const float rs = (CFG::SSQ ? SSQ_RSTD(rsv[ai][m]) : rsv[ai][m]) * CFG::POST;
#pragma unroll
                for (int bj = 0; bj < 2; ++bj) { const int lc = bj * HALF + wc * 32 + 8 * fq; int col = cb + lc; if (hp) col = (col >> 6) * 96 + (col & 63); float o[8];
#pragma unroll
                    for (int n = 0; n < 2; ++n)
#pragma unroll
                        for (int j = 0; j < 4; ++j) o[4 * n + j] = acc[ai][bj][m][n][j] * rs;
                    *(u32x4*)(base + (size_t)row * ld + col) = pack8(o);
                    if (CFG::GATES && u.pn == CFG::GPN && bj == 1 && wc == 1 && fq < 2) { float* gp = gates + (size_t)row * 16 + 8 * fq;
                        *(f32x4*)gp = (f32x4){o[0], o[1], o[2], o[3]}; *(f32x4*)(gp + 4) = (f32x4){o[4], o[5], o[6], o[7]}; } } }
    }
};
constexpr int SIG_SPLIT_PM = 192;
struct EpiSig {
    static constexpr bool MIDK = false;
    bf16_t* O0; bf16_t* O1; const float* rstd; float post;
    __device__ __forceinline__ void operator()(const f32x4 (&acc)[2][2][4][2], const Unit& u, int wr, int wc, int fr, int fq) const {
        float rsv[2][4]; bf16_t* const O = u.pm < SIG_SPLIT_PM ? O0 : O1;
#pragma unroll
        for (int ai = 0; ai < 2; ++ai)
#pragma unroll
            for (int m = 0; m < 4; ++m) rsv[ai][m] = rstd[EPI_ROWS(ai, m)];
#pragma unroll
        for (int ai = 0; ai < 2; ++ai)
#pragma unroll
            for (int m = 0; m < 4; ++m) { const int row = EPI_ROWS(ai, m); const float c1 = -LOG2E * post * SSQ_RSTD(rsv[ai][m]);
#pragma unroll
                for (int bj = 0; bj < 2; ++bj) { const int col = u.pn * BM + bj * HALF + wc * 32 + 8 * fq; float o[8];
#pragma unroll
                    for (int n = 0; n < 2; ++n)
#pragma unroll
                        for (int j = 0; j < 4; ++j) o[4 * n + j] = __builtin_amdgcn_rcpf(1.f + __builtin_amdgcn_exp2f(acc[ai][bj][m][n][j] * c1));
                    *(u32x4*)(O + (size_t)row * 2048 + col) = pack8(o); } }
    }
};
struct EpiMerge {
    static constexpr bool MIDK = true;
    bf16_t* T; const bf16_t* sig0; const bf16_t* sig1;
    __device__ __forceinline__ void mid(f32x4 (&acc)[2][2][4][2], const Unit& u, int wr, int wc, int fr, int fq) const {
        const bf16_t* const sig = u.pm < SIG_SPLIT_PM ? sig0 : sig1;
#pragma unroll
        for (int ai = 0; ai < 2; ++ai) { u32x4 sa[4][2], sb[4][2];
#pragma unroll
            for (int m = 0; m < 4; ++m)
#pragma unroll
                for (int bj = 0; bj < 2; ++bj) { const size_t o = (size_t)EPI_ROWS(ai, m) * 2048 + u.pn * BM + bj * HALF + wc * 32 + 8 * fq;
                    sa[m][bj] = *(const u32x4*)(sig + o); sb[m][bj] = *(const u32x4*)(sig + o + 1024); }
#pragma unroll
            for (int m = 0; m < 4; ++m)
#pragma unroll
                for (int bj = 0; bj < 2; ++bj) { float a[8], b[8]; unpack8(sa[m][bj], a); unpack8(sb[m][bj], b);
#pragma unroll
                    for (int n = 0; n < 2; ++n)
#pragma unroll
                        for (int j = 0; j < 4; ++j) acc[ai][bj][m][n][j] *= b[4 * n + j] * __builtin_amdgcn_rcpf(fmaxf(a[4 * n + j], 1e-30f)); } }
    }
    __device__ __forceinline__ void operator()(const f32x4 (&acc)[2][2][4][2], const Unit& u, int wr, int wc, int fr, int fq) const {
        const bf16_t* const sig = u.pm < SIG_SPLIT_PM ? sig0 : sig1;
        u32x4 sa[2][4][2];
#pragma unroll
        for (int ai = 0; ai < 2; ++ai)
#pragma unroll
            for (int m = 0; m < 4; ++m)
#pragma unroll
                for (int bj = 0; bj < 2; ++bj) sa[ai][m][bj] = *(const u32x4*)(sig + (size_t)EPI_ROWS(ai, m) * 2048 + u.pn * BM + bj * HALF + wc * 32 + 8 * fq);
#pragma unroll
        for (int ai = 0; ai < 2; ++ai) {
#pragma unroll
            for (int m = 0; m < 4; ++m)
#pragma unroll
                for (int bj = 0; bj < 2; ++bj) { float a[8], o[8]; unpack8(sa[ai][m][bj], a);
#pragma unroll
                    for (int n = 0; n < 2; ++n)
#pragma unroll
                        for (int j = 0; j < 4; ++j) o[4 * n + j] = acc[ai][bj][m][n][j] * fmaxf(a[4 * n + j], 1e-30f);
                    *(u32x4*)(T + (size_t)EPI_ROWS(ai, m) * DM + u.pn * BM + bj * HALF + wc * 32 + 8 * fq) = pack8(o); } }
    }
};
#undef EPI_ROWS
#undef SSQ_RSTD
}

namespace att {
constexpr int NW = 8, QBLK = 32, KVBLK = 64;
constexpr int LDQ = 768, LDK = 768, LDV = 512, LDO = 1024;
constexpr float THR = 4.f;
#define SBAR() __builtin_amdgcn_sched_barrier(0)
__device__ __forceinline__ int crow(int r, int hi) { return (r & 3) + 8 * (r >> 2) + 4 * hi; }
constexpr int KSLOT = 8192, VSLOT = 4096, L2_K = 0, L2_V = 4 * KSLOT, L2_WS = L2_V + 3 * VSLOT, L2_BYTES = L2_WS + NW * 64 * 4;
__device__ __forceinline__ void glds16(const void* gsrc, unsigned lds_dst) { unsigned keep;
  asm volatile("s_mov_b32 %0, m0\n\ts_mov_b32 m0, %2\n\ts_nop 0\n\tglobal_load_lds_dwordx4 %1, off\n\ts_mov_b32 m0, %0" : "=&s"(keep) : "v"(gsrc), "s"(lds_dst) : "memory"); }
__device__ __forceinline__ void pv2(f32x16* o, LAS const unsigned char* va, LAS const unsigned char* vb_, const i32x8 pa) {
#pragma unroll
  for (int d0 = 0; d0 < 2; ++d0) { const u32x4 lo = *(const LAS u32x4*)(va + d0 * 2048), hi_ = *(const LAS u32x4*)(vb_ + d0 * 2048);
    const i32x8 v8 = (i32x8){(int)lo.x, (int)lo.y, (int)lo.z, (int)lo.w, (int)hi_.x, (int)hi_.y, (int)hi_.z, (int)hi_.w};
    o[d0] = __builtin_amdgcn_mfma_scale_f32_32x32x64_f8f6f4(pa, v8, o[d0], 1  , 0  , 0, 0x7f7f7f7f, 0, 0x7f7f7f7f); }
}
template <bool FIRST> __device__ __forceinline__ void decideSM2(f32x16& p0, f32x16& p1, float& m_reg, float& l_reg, float& alpha) {
  float pmax = p0[0];
#pragma unroll
  for (int r = 1; r < 16; ++r) pmax = fmaxf(pmax, p0[r]);
#pragma unroll
  for (int r = 0; r < 16; ++r) pmax = fmaxf(pmax, p1[r]);
  { auto rr = __builtin_amdgcn_permlane32_swap(__float_as_uint(pmax), __float_as_uint(pmax), false, false);
    pmax = fmaxf(__uint_as_float(rr[0]), __uint_as_float(rr[1])); }
  alpha = 1.f;
  if (FIRST || !__builtin_expect(__all(pmax <= THR), 1)) {
    const float dl = FIRST ? pmax : fmaxf(pmax, 0.f);
    m_reg += dl;
#pragma unroll
    for (int r = 0; r < 16; ++r) { p0[r] -= dl; p1[r] -= dl; }
    if (!FIRST) { alpha = __builtin_amdgcn_exp2f(-dl); l_reg *= alpha; }
  }
}
__device__ __forceinline__ void finishSM2(f32x16& p0, f32x16& p1, float& l_reg, i32x8& pa) {
#pragma unroll
  for (int r = 0; r < 16; ++r) p0[r] = __builtin_amdgcn_exp2f(p0[r]);
#pragma unroll
  for (int r = 0; r < 16; ++r) p1[r] = __builtin_amdgcn_exp2f(p1[r]);
  float ps = 0;
#pragma unroll
  for (int r = 0; r < 16; ++r) ps += p0[r];
#pragma unroll
  for (int r = 0; r < 16; ++r) ps += p1[r];
  { auto rr = __builtin_amdgcn_permlane32_swap(__float_as_uint(ps), __float_as_uint(ps), false, false);
    ps = __uint_as_float(rr[0]) + __uint_as_float(rr[1]); }
  l_reg += ps;
#define PK4(P, B) (int)pack4_bf8(P[B], P[B + 1], P[B + 2], P[B + 3])
  pa = (i32x8){PK4(p0, 0), PK4(p0, 4), PK4(p0, 8), PK4(p0, 12), PK4(p1, 0), PK4(p1, 4), PK4(p1, 8), PK4(p1, 12)};
#undef PK4
}
constexpr int SC_ONE = 0x7f7f7f7f, SC_EIGHTH = 0x7c7c7c7c;
constexpr float POFF = -4.f;
template <bool ZC = false> __device__ __forceinline__ void qkt2r(f32x16& p0, f32x16& p1, const i32x8* kf8, LAS const unsigned char* kpE, LAS const unsigned char* kpO, const i32x8 q8, const bf16x8* qr, const float nm) {
  f32x16 negm;
#pragma unroll
  for (int r = 0; r < 16; ++r) negm[r] = ZC ? POFF : nm;
  const bf16x8 k8 = *(const LAS bf16x8*)(kpE), k9 = *(const LAS bf16x8*)(kpE + 2048), k10 = *(const LAS bf16x8*)(kpO), k11 = *(const LAS bf16x8*)(kpO + 2048);
  p0 = __builtin_amdgcn_mfma_scale_f32_32x32x64_f8f6f4(kf8[0], q8, negm, 0, 0, 0, SC_ONE, 0, SC_EIGHTH);
  p1 = __builtin_amdgcn_mfma_scale_f32_32x32x64_f8f6f4(kf8[1], q8, negm, 0, 0, 0, SC_ONE, 0, SC_EIGHTH);
  p0 = __builtin_amdgcn_mfma_f32_32x32x16_bf16(k8, qr[0], p0, 0, 0, 0); p1 = __builtin_amdgcn_mfma_f32_32x32x16_bf16(k9, qr[0], p1, 0, 0, 0);
  p0 = __builtin_amdgcn_mfma_f32_32x32x16_bf16(k10, qr[1], p0, 0, 0, 0); p1 = __builtin_amdgcn_mfma_f32_32x32x16_bf16(k11, qr[1], p1, 0, 0, 0);
}
__device__ __forceinline__ void kload8(i32x8* kf8, LAS const unsigned char* kpa, LAS const unsigned char* kpb) {
#pragma unroll
  for (int b = 0; b < 2; ++b) { const u32x4 lo = *(const LAS u32x4*)(kpa + b * 2048), hi_ = *(const LAS u32x4*)(kpb + b * 2048);
    kf8[b] = (i32x8){(int)lo.x, (int)lo.y, (int)lo.z, (int)lo.w, (int)hi_.x, (int)hi_.y, (int)hi_.z, (int)hi_.w}; }
}
template <bool NOMAX> __device__ __forceinline__ void attn_unit2(const bf16_t* __restrict__ Qb, const bf16_t* __restrict__ Kh, const unsigned char* __restrict__ Vt, bf16_t* __restrict__ Ob, int seq, char* shm, const int wv) {
  int lane = lane_id(); asm volatile("" : "+v"(lane));
  const int wid = wv, r32 = lane & 31, hi = lane >> 5;
  const unsigned lds0 = (unsigned)(uintptr_t)shm;
  LAS const unsigned char* shm3 = (LAS const unsigned char*)shm;
  float* ws = (float*)(shm + L2_WS) + wid * 64; float* li_l = ws; float* al_l = ws + 32;
  const int kcl = (lane & 3) ^ ((lane >> 4) & 3);
  const bf16_t* ksrcA = Kh + (long)((wid & 3) * 16 + (lane >> 2)) * LDK + (wid >> 2) * 64 + kcl * 8;
  const unsigned char* vsrc = Vt + (wid & 3) * 1024 + lane * 16; const bool vw = wid < 4;
  const unsigned kdstA = lds0 + L2_K + wid * 1024, vdst = lds0 + L2_V + (wid & 3) * 1024;
#define DMA_K(t, ks) glds16(ksrcA + (long)(t) * KVBLK * LDK, (unsigned)__builtin_amdgcn_readfirstlane(kdstA + (ks)))
#define DMA_V(t, vs) do { if (vw) glds16(vsrc + (long)(t) * 4096, (unsigned)__builtin_amdgcn_readfirstlane(vdst + (vs))); } while (0)
#define WAITBAR(N) asm volatile("s_waitcnt vmcnt(" #N ") lgkmcnt(0)\n\ts_barrier" ::: "memory")
#define WAITBAR2() do { if (vw) WAITBAR(2); else WAITBAR(1); } while (0)
  const int kswz = (r32 >> 2) & 3, krow = (r32 >> 4) * 1024 + (r32 & 15) * 64;
  LAS const unsigned char* kpa = shm3 + L2_K + krow + (((2 * hi) ^ kswz) * 16);
  LAS const unsigned char* kpb = shm3 + L2_K + krow + (((2 * hi + 1) ^ kswz) * 16);
  LAS const unsigned char* kp0 = shm3 + L2_K + 4096 + krow + ((hi ^ kswz) * 16);
  LAS const unsigned char* kp1 = shm3 + L2_K + 4096 + krow + (((2 + hi) ^ kswz) * 16);
  LAS const unsigned char* va0 = shm3 + L2_V + r32 * 64 + (((2 * hi) ^ kswz) * 16);
  LAS const unsigned char* vb0 = shm3 + L2_V + r32 * 64 + (((2 * hi + 1) ^ kswz) * 16);
  const int NT = seq / KVBLK;
  DMA_K(0, 0); DMA_V(0, 0); DMA_K(1, KSLOT); DMA_K(2, 2 * KSLOT);
  float m_reg = 0.f, l_reg = 0; f32x16 o[2] = {}; bf16x8 qr[2]; i32x8 q8, kf[2];
  const bf16_t* Qw = Qb + (long)(wid * QBLK + r32) * LDQ;
  { const u32x4 qa = *reinterpret_cast<const u32x4*>((const char*)Qw + hi * 32), qb_ = *reinterpret_cast<const u32x4*>((const char*)Qw + hi * 32 + 16);
    q8 = (i32x8){(int)qa.x, (int)qa.y, (int)qa.z, (int)qa.w, (int)qb_.x, (int)qb_.y, (int)qb_.z, (int)qb_.w}; }
#pragma unroll
  for (int d0 = 0; d0 < 2; ++d0) qr[d0] = *reinterpret_cast<const bf16x8*>(Qw + 64 + hi * 8 + d0 * 16);
#define RESC2(a) do { if (__any((a) < 1.f)) { if (hi == 0) al_l[r32] = (a); asm volatile("s_waitcnt lgkmcnt(0)" ::: "memory"); \
    _Pragma("unroll") for (int d = 0; d < 2; ++d) _Pragma("unroll") for (int r = 0; r < 16; ++r) o[d][r] *= al_l[crow(r, hi)]; } } while (0)
  f32x16 pA0, pA1, pB0, pB1; float alA, alB; i32x8 pa;
  asm volatile("" : "+v"(qr[0]), "+v"(qr[1]), "+v"(q8));
  WAITBAR(0);
  int k0s = 0, k1s = KSLOT, k2s = 2 * KSLOT, k3s = 3 * KSLOT, vm1s = 2 * VSLOT, v0s = 0, v1s = VSLOT;
#define ROT2() do { const int tk = k0s; k0s = k1s; k1s = k2s; k2s = k3s; k3s = tk; const int tv = vm1s; vm1s = v0s; v0s = v1s; v1s = tv; } while (0)
  kload8(kf, kpa + k0s, kpb + k0s); asm volatile("s_waitcnt lgkmcnt(0)\n\ts_barrier" ::: "memory");
  DMA_K(3, k3s); DMA_V(1, v1s);
  qkt2r<true>(pA0, pA1, kf, kp0 + k0s, kp1 + k0s, q8, qr, 0.f); SBAR(); kload8(kf, kpa + k1s, kpb + k1s); if (!NOMAX) decideSM2<true>(pA0, pA1, m_reg, l_reg, alA);
  WAITBAR2(); ROT2();
  for (int j = 1; j + 1 < NT; j += 2) {
    if (j + 3 < NT) { DMA_K(j + 3, k3s); DMA_V(j + 1, v1s); } else { DMA_V(j + 1, v1s); }
    SBAR(); qkt2r<NOMAX>(pB0, pB1, kf, kp0 + k0s, kp1 + k0s, q8, qr, -m_reg);
    finishSM2(pA0, pA1, l_reg, pa); SBAR();
    pv2(o, va0 + vm1s, vb0 + vm1s, pa); kload8(kf, kpa + k1s, kpb + k1s); if (!NOMAX) { decideSM2<false>(pB0, pB1, m_reg, l_reg, alB);
    RESC2(alB); } if (j + 3 < NT) WAITBAR2(); else WAITBAR(0); ROT2();
    if (j + 4 < NT) { DMA_K(j + 4, k3s); DMA_V(j + 2, v1s); } else if (j + 2 < NT) { DMA_V(j + 2, v1s); }
    SBAR(); qkt2r<NOMAX>(pA0, pA1, kf, kp0 + k0s, kp1 + k0s, q8, qr, -m_reg);
    finishSM2(pB0, pB1, l_reg, pa); SBAR();
    pv2(o, va0 + vm1s, vb0 + vm1s, pa); if (j + 2 < NT) kload8(kf, kpa + k1s, kpb + k1s); if (!NOMAX) { decideSM2<false>(pA0, pA1, m_reg, l_reg, alA);
    RESC2(alA); } if (j + 4 < NT) WAITBAR2(); else WAITBAR(0); ROT2();
  }
  SBAR(); qkt2r<NOMAX>(pB0, pB1, kf, kp0 + k0s, kp1 + k0s, q8, qr, -m_reg);
  finishSM2(pA0, pA1, l_reg, pa); SBAR();
  pv2(o, va0 + vm1s, vb0 + vm1s, pa); if (!NOMAX) { decideSM2<false>(pB0, pB1, m_reg, l_reg, alB);
  RESC2(alB); }
  finishSM2(pB0, pB1, l_reg, pa); SBAR();
  pv2(o, va0 + v0s, vb0 + v0s, pa);
  if (hi == 0) li_l[r32] = l_reg; asm volatile("s_waitcnt lgkmcnt(0)" ::: "memory");
  float rli[16];
#pragma unroll
  for (int r = 0; r < 16; ++r) rli[r] = __builtin_amdgcn_rcpf(li_l[crow(r, hi)]);
  bf16_t* Ow = Ob + (long)(wid * QBLK) * LDO;
#pragma unroll
  for (int r = 0; r < 16; ++r) { const int orow = crow(r, hi);
#pragma unroll
    for (int d0 = 0; d0 < 2; ++d0) Ow[(long)orow * LDO + d0 * 32 + r32] = f2bf(o[d0][r] * rli[r]); }
  asm volatile("s_waitcnt vmcnt(0) lgkmcnt(0)\n\ts_barrier" ::: "memory");
#undef DMA_K
#undef DMA_V
#undef WAITBAR
#undef WAITBAR2
#undef RESC2
#undef ROT2
}
#undef SBAR
}

namespace ml {
constexpr int LQ = 136;
constexpr int LV = 84;
constexpr int NBV = 5;
constexpr int SLV = 128 * LV * 2, SLCT = 80 * LQ * 2;
constexpr int OFF_Q = 0, OFF_K = 34816, OFF_V = 69632, OFF_CT = OFF_V + 2 * SLV, OFF_VEC = OFF_CT + 2 * SLCT;
constexpr int LDS_BYTES = OFF_VEC + 1480 * 4;
typedef short v4i16_t __attribute__((ext_vector_type(4)));
__device__ __forceinline__ s16x4 vtr(LAS const unsigned char* p) { return __builtin_bit_cast(s16x4, __builtin_amdgcn_ds_read_tr16_b64_v4i16((LAS v4i16_t*)p)); }
__device__ __forceinline__ bf16x8 tr_frag(LAS const unsigned char* base, int stride_b, int k0, int n0, int lane) {
    const int g = lane >> 4, q = (lane & 15) >> 2, p = lane & 3;
    LAS const unsigned char* a = base + (k0 + 8 * g + q) * stride_b + (n0 + 4 * p) * 2;
    const s16x4 lo = vtr(a), hi = vtr(a + 4 * stride_b);
    return (bf16x8){lo[0], lo[1], lo[2], lo[3], hi[0], hi[1], hi[2], hi[3]};
}
__device__ __forceinline__ float log_sigmoid(float x) { return fminf(x, 0.f) - log1pf(expf(-fabsf(x))); }

__device__ __forceinline__ void gate_scan(const float* __restrict__ gates, int b, int h, int dir, int cs, float bi, float bfv, float* __restrict__ gp, float* __restrict__ tp, int lane) {
    const int oc = dir ? 63 - cs : cs; const long t0 = (long)b * SEQ + (long)oc * 128;
    const int l0 = 2 * lane, l1 = l0 + 1; const long k0 = t0 + (dir ? 127 - l0 : l0), k1 = t0 + (dir ? 127 - l1 : l1);
    const float i0 = gates[k0 * 16 + dir * 4 + h] + bi, i1 = gates[k1 * 16 + dir * 4 + h] + bi;
    const float f0 = log_sigmoid(gates[k0 * 16 + 8 + dir * 4 + h] + bfv), f1 = log_sigmoid(gates[k1 * 16 + 8 + dir * 4 + h] + bfv);
    float x = f0 + f1;
#pragma unroll
    for (int o = 1; o < 64; o <<= 1) { const float y = __shfl_up(x, o); if (lane >= o) x += y; }
    const float b1 = x, b0 = x - f1;
    const float a0 = i0 - b0, a1 = i1 - b1;
    float mx = fmaxf(a0, a1);
#pragma unroll
    for (int o = 1; o < 64; o <<= 1) { const float y = __shfl_up(mx, o); if (lane >= o) mx = fmaxf(mx, y); }
    float ex = __shfl_up(mx, 1); if (lane == 0) ex = -INFINITY;
    const float pm0 = fmaxf(ex, a0), pm1 = fmaxf(pm0, a1);
    *(f32x2*)(gp + l0) = (f32x2){a0, a1}; *(f32x2*)(gp + 128 + l0) = (f32x2){b0, b1}; *(f32x2*)(gp + 256 + l0) = (f32x2){pm0, pm1};
    if (lane == 63) { tp[0] = b1; tp[1] = pm1; }
}

__device__ __forceinline__ void chain(LAS unsigned char* L, int b, int h, int dir, const bf16_t* __restrict__ mqkv,
                                      bf16_t* __restrict__ hout, const float* __restrict__ gsc, const float* __restrict__ totg, const int wv) {
    int lane = lane_id(); asm volatile("" : "+v"(lane));
    const int w = wv, tid = wv * 64 + lane, c = lane & 15, g = lane >> 4, rq = (wv < 4) ? wv : 11 - wv;
    const unsigned lbase = (unsigned)(__UINTPTR_TYPE__)L;
    LAS float* vecs = (LAS float*)(L + OFF_VEC); LAS float* mprev = vecs + 1280; LAS float* tot = mprev + 64; LAS float* dec = tot + 128;
    const size_t qoff = (size_t)h * 128, koff = 512 + (size_t)h * 128, voff = 1024 + (size_t)h * 128;
    if (tid < 128) tot[tid] = totg[tid];
    __syncthreads();
    if (tid == 0) { float m = 0.f; for (int cs = 0; cs < 64; ++cs) { mprev[cs] = m; m = tot[2 * cs] + fmaxf(m, tot[2 * cs + 1]); } }
    __syncthreads();
#define ML_VECS(cs_, ga_, gb_, gpm_) do { LAS float* vb_ = vecs + ((cs_) & 1) * 640; const float mp_ = mprev[cs_]; const float pmL_ = tot[2 * (cs_) + 1]; const float ML_ = fmaxf(pmL_, mp_), M_ = fmaxf(gpm_, mp_); \
        vb_[tid] = ga_; vb_[128 + tid] = M_; vb_[256 + tid] = __expf(ga_ - ML_); vb_[384 + tid] = __expf(mp_ - M_); vb_[512 + tid] = __expf(-(gb_) - M_); if (tid == 0) dec[(cs_) & 1] = __expf(mp_ - ML_); } while (0)
    f32x4 st[2][NBV];
#pragma unroll
    for (int s_ = 0; s_ < 2; ++s_)
#pragma unroll
        for (int rb = 0; rb < NBV; ++rb) st[s_][rb] = (f32x4){0.f, 0.f, 0.f, 0.f};
    bf16x8 qv[4], kv[4]; u32x4 vraw[2][2]; float ga = 0.f, gb = 0.f, gpm = 0.f;
    const int cc16 = tid & 15, vrow = tid >> 3, vcc = tid & 7;
    const __amdgpu_buffer_rsrc_t rsrc = __builtin_amdgcn_make_buffer_rsrc((void*)mqkv, 0, (int)((size_t)M * 1536 * 2), 0x00020000);
    const unsigned r0 = (unsigned)(tid >> 4), qk_vo = ((dir ? 31u - r0 : r0) * 1536u + (unsigned)cc16 * 8u) * 2u;
    const unsigned v_vo = ((dir ? 63u - (unsigned)vrow : (unsigned)vrow) * 1536u + (unsigned)vcc * 8u) * 2u;
#define ML_LOAD(cs_) do { const int oc_ = dir ? 63 - (cs_) : (cs_); const unsigned cb_ = (unsigned)(((size_t)b * SEQ + (size_t)oc_ * 128) * 1536 * 2); \
        _Pragma("unroll") for (int j = 0; j < 4; ++j) { const unsigned so_ = cb_ + (unsigned)((dir ? 3 - j : j) * 32 * 1536 * 2); \
            qv[j] = __builtin_bit_cast(bf16x8, __builtin_amdgcn_raw_buffer_load_b128(rsrc, qk_vo, so_ + (unsigned)qoff * 2u, 0)); \
            kv[j] = __builtin_bit_cast(bf16x8, __builtin_amdgcn_raw_buffer_load_b128(rsrc, qk_vo, so_ + (unsigned)koff * 2u, 0)); } \
        _Pragma("unroll") for (int s_ = 0; s_ < 2; ++s_) _Pragma("unroll") for (int j = 0; j < 2; ++j) { const unsigned so_ = cb_ + (unsigned)((dir ? 1 - j : j) * 64 * 1536 * 2) + (unsigned)(voff + 64 * s_) * 2u; \
            vraw[s_][j] = __builtin_bit_cast(u32x4, __builtin_amdgcn_raw_buffer_load_b128(rsrc, v_vo, so_, 0)); } \
        if (w < 2) { const float* gp_ = gsc + (size_t)(cs_) * 384 + tid; ga = gp_[0]; gb = gp_[128]; gpm = gp_[256]; } } while (0)
    ML_LOAD(0);
    if (w < 2) ML_VECS(0, ga, gb, gpm);
    __syncthreads();
    for (int cs = 0; cs < 64; ++cs) {
        int lane_ = lane; asm volatile("" : "+v"(lane_)); const int lane = lane_, c = lane & 15, g = lane >> 4, tid = w * 64 + lane, cc16 = tid & 15, vrow = tid >> 3, vcc = tid & 7; (void)vcc; (void)vrow; (void)cc16;
        const int oc = dir ? 63 - cs : cs; bf16_t* hb_ = hout + ((size_t)b * SEQ + (size_t)oc * 128) * 512;
        LAS float* vb = vecs + (cs & 1) * 640; LAS float* avec = vb; LAS float* Mvec = vb + 128; LAS float* wsvec = vb + 256; LAS float* iwvec = vb + 384; LAS float* emvec = vb + 512;
#pragma unroll
        for (int j = 0; j < 4; ++j) { const int row = (tid >> 4) + 32 * j;
            *(LAS bf16x8*)(L + OFF_Q + (row * LQ + cc16 * 8) * 2) = qv[j]; *(LAS bf16x8*)(L + OFF_K + (row * LQ + cc16 * 8) * 2) = kv[j]; }
#pragma unroll
        for (int s_ = 0; s_ < 2; ++s_)
#pragma unroll
        for (int j = 0; j < 2; ++j) { const int row = vrow + 64 * j; LAS unsigned char* vp = L + OFF_V + s_ * SLV + (row * LV + vcc * 8) * 2;
            *(LAS u32x2*)vp = (u32x2){vraw[s_][j].x, vraw[s_][j].y}; *(LAS u32x2*)(vp + 8) = (u32x2){vraw[s_][j].z, vraw[s_][j].w};
            if (vcc == 0) { LAS unsigned char* v1 = L + OFF_V + s_ * SLV + (row * LV + 64) * 2;
                *(LAS u32x2*)v1 = (u32x2){0x00003f80u, 0u}; *(LAS u32x2*)(v1 + 8) = (u32x2){0u, 0u}; *(LAS u32x2*)(v1 + 16) = (u32x2){0u, 0u}; *(LAS u32x2*)(v1 + 24) = (u32x2){0u, 0u}; } }
#pragma unroll
        for (int s_ = 0; s_ < 2; ++s_)
#pragma unroll
        for (int rb = 0; rb < NBV - s_; ++rb)
#pragma unroll
            for (int i = 0; i < 4; ++i) *(LAS bf16_t*)(L + OFF_CT + s_ * SLCT + ((16 * rb + 4 * g + i) * LQ + 16 * w + c) * 2) = f2bf(st[s_][rb][i]);
        __syncthreads();
#define LR128(dst, addr, OFF) asm volatile("ds_read_b128 %0, %1 offset:%c2" : "=&v"(dst) : "v"(addr), "i"(OFF) : "memory")
#define LRTR(dst, addr, OFF) asm volatile("ds_read_b64_tr_b16 %0, %1 offset:%c2" : "=&v"(dst) : "v"(addr), "i"(OFF) : "memory")
#define LWAIT_NB(NB) do { if (NB == 5) { LWAIT(11); } else { LWAIT(9); } } while (0)
#define LWAIT(N) do { asm volatile("s_waitcnt lgkmcnt(" #N ")" ::: "memory"); __builtin_amdgcn_sched_barrier(0); } while (0)
#define TRF(lo_, hi_) (bf16x8){lo_[0], lo_[1], lo_[2], lo_[3], hi_[0], hi_[1], hi_[2], hi_[3]}
        const unsigned rowA = lbase + OFF_Q + ((16 * rq + c) * LQ + 8 * g) * 2;
        const unsigned kB = lbase + OFF_K + (c * LQ + 8 * g) * 2;
        const unsigned ctB = lbase + OFF_CT + (c * LQ + 8 * g) * 2;
        const unsigned vT = lbase + OFF_V + ((8 * g + ((lane & 15) >> 2)) * LV + 4 * (lane & 3)) * 2;
        const unsigned kT = lbase + OFF_K + ((8 * g + ((lane & 15) >> 2)) * LQ + 16 * w + 4 * (lane & 3)) * 2;
        bf16x8 aq[4], fa[8];
#define CT4(CB, F, o, nb) do { LR128(F[(o) + 0], CB, 4352 * (nb)); LR128(F[(o) + 1], CB, 4352 * (nb) + 64); LR128(F[(o) + 2], CB, 4352 * (nb) + 128); LR128(F[(o) + 3], CB, 4352 * (nb) + 192); } while (0)
#define QCM(nb, F, o) do { QC[nb] = __builtin_amdgcn_mfma_f32_16x16x32_bf16(aq[0], F[(o)], (f32x4){0.f, 0.f, 0.f, 0.f}, 0, 0, 0); _Pragma("unroll") for (int ks = 1; ks < 4; ++ks) QC[nb] = __builtin_amdgcn_mfma_f32_16x16x32_bf16(aq[ks], F[(o) + ks], QC[nb], 0, 0, 0); } while (0)
#define KPAIR(p) do { LR128(fa[0], kB, 8704 * (p)); LR128(fa[1], kB, 8704 * (p) + 64); LR128(fa[2], kB, 8704 * (p) + 128); LR128(fa[3], kB, 8704 * (p) + 192); \
                      LR128(fa[4], kB, 8704 * (p) + 4352); LR128(fa[5], kB, 8704 * (p) + 4352 + 64); LR128(fa[6], kB, 8704 * (p) + 4352 + 128); LR128(fa[7], kB, 8704 * (p) + 4352 + 192); } while (0)
#define KPAIRB(p) do { LR128(fb[0], kB, 8704 * (p)); LR128(fb[1], kB, 8704 * (p) + 64); LR128(fb[2], kB, 8704 * (p) + 128); LR128(fb[3], kB, 8704 * (p) + 192); \
                       LR128(fb[4], kB, 8704 * (p) + 4352); LR128(fb[5], kB, 8704 * (p) + 4352 + 64); LR128(fb[6], kB, 8704 * (p) + 4352 + 128); LR128(fb[7], kB, 8704 * (p) + 4352 + 192); } while (0)
        float Mt[4];
#pragma unroll
        for (int i = 0; i < 4; ++i) { const int t = 16 * rq + 4 * g + i; Mt[i] = Mvec[t]; }
        LR128(aq[0], rowA, 0); LR128(aq[1], rowA, 64); LR128(aq[2], rowA, 128); LR128(aq[3], rowA, 192);
        KPAIR(0);
#define SMM(S0, S1) do { S0 = __builtin_amdgcn_mfma_f32_16x16x32_bf16(aq[0], fa[0], (f32x4){0.f, 0.f, 0.f, 0.f}, 0, 0, 0); S1 = __builtin_amdgcn_mfma_f32_16x16x32_bf16(aq[0], fa[4], (f32x4){0.f, 0.f, 0.f, 0.f}, 0, 0, 0); \
            _Pragma("unroll") for (int ks = 1; ks < 4; ++ks) { S0 = __builtin_amdgcn_mfma_f32_16x16x32_bf16(aq[ks], fa[ks], S0, 0, 0, 0); S1 = __builtin_amdgcn_mfma_f32_16x16x32_bf16(aq[ks], fa[4 + ks], S1, 0, 0, 0); } \
            __builtin_amdgcn_sched_barrier(0); } while (0)
#define SAS(p, A0, A1) do { A0 = avec[32 * (p) + c]; A1 = avec[32 * (p) + 16 + c]; } while (0)
#define SEPI(p, S0, S1, A0, A1) do { _Pragma("unroll") for (int e = 0; e < 2; ++e) { const int nb = 2 * (p) + e; const f32x4 S = e ? S1 : S0; \
                if (nb <= rq) { const float as = e ? A1 : A0; \
                    _Pragma("unroll") for (int i = 0; i < 4; ++i) { float dv = __builtin_amdgcn_exp2f((as - Mt[i]) * LOG2E); if (nb == rq && c > 4 * g + i) dv = 0.f; \
                        *(LAS bf16_t*)(L + OFF_Q + ((16 * rq + 4 * g + i) * LQ + 16 * nb + c) * 2) = f2bf(S[i] * dv); } } \
                else if (nb == rq + 1) { _Pragma("unroll") for (int i = 0; i < 4; ++i) *(LAS bf16_t*)(L + OFF_Q + ((16 * rq + 4 * g + i) * LQ + 16 * nb + c) * 2) = (bf16_t)0; } } } while (0)
        const int npair = (rq >> 1) + 1;
        { f32x4 Sa, Sb; float a0, a1, b0, b1;
#define TOUCH2(A0, A1) asm volatile("" : "+v"(A0), "+v"(A1))
          SAS(0, a0, a1); LWAIT(0); TOUCH2(a0, a1); asm volatile("" : "+v"(Mt[0]), "+v"(Mt[1]), "+v"(Mt[2]), "+v"(Mt[3])); SMM(Sa, Sb);
          if (npair > 1) { SAS(1, b0, b1); KPAIR(1); }
          SEPI(0, Sa, Sb, a0, a1);
          if (npair > 1) { LWAIT(0); TOUCH2(b0, b1); SMM(Sa, Sb);
              if (npair > 2) { SAS(2, a0, a1); KPAIR(2); }
              SEPI(1, Sa, Sb, b0, b1);
              if (npair > 2) { LWAIT(0); TOUCH2(a0, a1); SMM(Sa, Sb);
                  if (npair > 3) { SAS(3, b0, b1); KPAIR(3); }
                  SEPI(2, Sa, Sb, a0, a1);
                  if (npair > 3) { LWAIT(0); TOUCH2(b0, b1); SMM(Sa, Sb); SEPI(3, Sa, Sb, b0, b1); } } } }
#undef TOUCH2
#undef SMM
#undef SAS
#undef SEPI
#undef KPAIR
#undef KPAIRB
        f32x4 QC[NBV];
        CT4(ctB, fa, 0, 0); CT4(ctB, fa, 4, 1);
        LWAIT(4); QCM(0, fa, 0); __builtin_amdgcn_sched_barrier(0); CT4(ctB, fa, 0, 2);
        LWAIT(4); QCM(1, fa, 4); __builtin_amdgcn_sched_barrier(0); CT4(ctB, fa, 4, 3);
        LWAIT(4); QCM(2, fa, 0); __builtin_amdgcn_sched_barrier(0); CT4(ctB, fa, 0, 4);
        LWAIT(4); QCM(3, fa, 4); __builtin_amdgcn_sched_barrier(0);
        LWAIT(0); QCM(4, fa, 0); __builtin_amdgcn_sched_barrier(0);
        f32x4 N[NBV];
        asm volatile("s_waitcnt lgkmcnt(0)" ::: "memory");
#define NREADS(VT, ks, B, NB) do { LR128(sa[B], rowA, 64 * (ks)); _Pragma("unroll") for (int nb = 0; nb < NB; ++nb) { LRTR(vlo[B][nb], VT, 5376 * (ks) + 32 * nb); LRTR(vhi[B][nb], VT, 5376 * (ks) + 32 * nb + 672); } } while (0)
#define NMFMA(B, NB) do { _Pragma("unroll") for (int nb = 0; nb < NB; ++nb) N[nb] = __builtin_amdgcn_mfma_f32_16x16x32_bf16(sa[B], TRF(vlo[B][nb], vhi[B][nb]), N[nb], 0, 0, 0); __builtin_amdgcn_sched_barrier(0); } while (0)
#define NMFMA0(B, NB) do { _Pragma("unroll") for (int nb = 0; nb < NB; ++nb) N[nb] = __builtin_amdgcn_mfma_f32_16x16x32_bf16(sa[B], TRF(vlo[B][nb], vhi[B][nb]), (f32x4){0.f, 0.f, 0.f, 0.f}, 0, 0, 0); __builtin_amdgcn_sched_barrier(0); } while (0)
#define NUM_H(VT, CO, NB) do { { bf16x8 sa[2]; s16x4 vlo[2][NBV], vhi[2][NBV]; \
          NREADS(VT, 0, 0, NB); \
          if (npair > 1) { NREADS(VT, 1, 1, NB); LWAIT_NB(NB); } else { LWAIT(0); } \
          NMFMA0(0, NB); \
          if (npair > 1) { if (npair > 2) { NREADS(VT, 2, 0, NB); LWAIT_NB(NB); } else { LWAIT(0); } \
              NMFMA(1, NB); \
              if (npair > 2) { if (npair > 3) { NREADS(VT, 3, 1, NB); LWAIT_NB(NB); } else { LWAIT(0); } \
                  NMFMA(0, NB); \
                  if (npair > 3) { LWAIT(0); NMFMA(1, NB); } } } } \
        _Pragma("unroll") for (int i = 0; i < 4; ++i) { const int t = 16 * rq + 4 * g + i; const float iwt_ = iwvec[t]; \
            if (NB == NBV) { const float emt_ = emvec[t]; const float dn = N[NBV - 1][i] + iwt_ * QC[NBV - 1][i]; const float den = __shfl(dn, lane & 48); \
                rdv[i] = __builtin_amdgcn_rcpf(fmaxf(fabsf(den), emt_)); }        \
            const float rd = rdv[i]; \
            const unsigned ho = (unsigned)(dir ? 127 - t : t) * 512u + (unsigned)(h * 128 + (CO) + c); \
            _Pragma("unroll") for (int nb = 0; nb < NBV - 1; ++nb) hb_[ho + 16 * nb] = f2bf((N[nb][i] + iwt_ * QC[nb][i]) * rd); } } while (0)
        float rdv[4];
        NUM_H(vT, 0, 5);
        if (cs + 1 < 64) ML_LOAD(cs + 1);
        { const unsigned ctB1 = ctB + SLCT;
          CT4(ctB1, fa, 0, 0); CT4(ctB1, fa, 4, 1);
          LWAIT(4); QCM(0, fa, 0); __builtin_amdgcn_sched_barrier(0); CT4(ctB1, fa, 0, 2);
          LWAIT(4); QCM(1, fa, 4); __builtin_amdgcn_sched_barrier(0); CT4(ctB1, fa, 4, 3);
          LWAIT(4); QCM(2, fa, 0); __builtin_amdgcn_sched_barrier(0);
          LWAIT(0); QCM(3, fa, 4); __builtin_amdgcn_sched_barrier(0); }
        { const unsigned vT1 = vT + SLV; NUM_H(vT1, 64, 4); }
#undef NUM_H
#undef NREADS
#undef NMFMA
#undef NMFMA0
#undef CT4
#undef QCM
        const float decay = dec[cs & 1];
#define UREADS(VT, ks, B, NB) do { LRTR(klo[B], kT, 8704 * (ks)); LRTR(khi[B], kT, 8704 * (ks) + 1088); _Pragma("unroll") for (int rb = 0; rb < NB; ++rb) { LRTR(vlo[B][rb], VT, 5376 * (ks) + 32 * rb); LRTR(vhi[B][rb], VT, 5376 * (ks) + 32 * rb + 672); } } while (0)
#define UMFMA(ST, ks, B, NB) do { const f32x4 w0 = *(const LAS f32x4*)(wsvec + 32 * (ks) + 8 * g), w1 = *(const LAS f32x4*)(wsvec + 32 * (ks) + 8 * g + 4); \
            float kf_[8]; unpack8(__builtin_bit_cast(u32x4, TRF(klo[B], khi[B])), kf_); \
            kf_[0] *= w0[0]; kf_[1] *= w0[1]; kf_[2] *= w0[2]; kf_[3] *= w0[3]; kf_[4] *= w1[0]; kf_[5] *= w1[1]; kf_[6] *= w1[2]; kf_[7] *= w1[3]; \
            const bf16x8 bk = __builtin_bit_cast(bf16x8, pack8(kf_)); \
            _Pragma("unroll") for (int rb = 0; rb < NB; ++rb) ST[rb] = __builtin_amdgcn_mfma_f32_16x16x32_bf16(TRF(vlo[B][rb], vhi[B][rb]), bk, ST[rb], 0, 0, 0); __builtin_amdgcn_sched_barrier(0); } while (0)
#define UPDATE(ST, VT, NB) do { _Pragma("unroll") for (int rb = 0; rb < NB; ++rb) ST[rb] = ST[rb] * decay; \
          { s16x4 klo[2], khi[2], vlo[2][NBV], vhi[2][NBV]; \
          UREADS(VT, 0, 0, NB); UREADS(VT, 1, 1, NB); LWAIT_U(NB); UMFMA(ST, 0, 0, NB); \
          UREADS(VT, 2, 0, NB); LWAIT_U(NB); UMFMA(ST, 1, 1, NB); \
          UREADS(VT, 3, 1, NB); LWAIT_U(NB); UMFMA(ST, 2, 0, NB); \
          LWAIT(0); UMFMA(ST, 3, 1, NB); } } while (0)
#define LWAIT_U(NB) do { if (NB == 5) { LWAIT(12); } else { LWAIT(10); } } while (0)
        UPDATE(st[0], vT, 5);
        { const unsigned vT1 = vT + SLV; UPDATE(st[1], vT1, 4); }
#undef UPDATE
#undef LWAIT_U
#undef UREADS
#undef UMFMA
#undef LR128
#undef LRTR
#undef LWAIT
#undef LWAIT_NB
#undef TRF
        if (cs + 1 < 64 && w < 2) ML_VECS(cs + 1, ga, gb, gpm);
        __syncthreads();
    }
#undef ML_VECS
#undef ML_LOAD
}
}

#define XB_TMO      128
#define XB_XCNT(j)  (256  + 64 * (j))
#define XB_XSUB(j)  (1280 + 64 * (j))
#define XB_XGEN(j)  (2304 + 64 * (j))
#define XB_TOP      3328
#define XB_TOPGEN   3392
#define XCD_BAR_WORDS 3456
#define XB_SPIN_CAP (1u << 21)

__device__ __forceinline__ unsigned xb_ld(unsigned* p)              { return __hip_atomic_load(p, __ATOMIC_RELAXED, __HIP_MEMORY_SCOPE_AGENT); }
__device__ __forceinline__ unsigned xb_add(unsigned* p, unsigned v) { return __hip_atomic_fetch_add(p, v, __ATOMIC_RELAXED, __HIP_MEMORY_SCOPE_AGENT); }
__device__ __forceinline__ unsigned xb_xcc_id() { return (unsigned)__builtin_amdgcn_s_getreg((3 << 11) | 20) & 0xFu; }
#define XB_SPIN(cond, bar) do { unsigned _sp = 0; while (cond) { __builtin_amdgcn_s_sleep(1); \
    if ((++_sp & 255u) == 0u) { if (xb_ld(&(bar)[XB_TMO])) break; if (_sp > XB_SPIN_CAP) { atomicAdd(&(bar)[XB_TMO], 1u); break; } } } } while (0)

struct XcdBarrier { unsigned* bar; unsigned x; volatile LAS unsigned* st; };

__device__ __forceinline__ XcdBarrier xcd_barrier_post(unsigned* bar, volatile LAS unsigned* st, const int wv) {
    XcdBarrier b; b.bar = bar; b.x = xb_xcc_id(); b.st = st;
    if (wv == 0 && lane_id() == 0) (void)xb_add(&bar[XB_XCNT(b.x)], 1u);
    return b;
}
__device__ __forceinline__ void xcd_barrier_complete(unsigned* bar, unsigned x, unsigned& nloc, unsigned& nx) {
    const unsigned G = gridDim.x * gridDim.y * gridDim.z;
    unsigned sum, cnt, mine, sp = 0u;
    for (;;) {
        sum = 0u; cnt = 0u; mine = 0u;
#pragma unroll
        for (unsigned j = 0; j < 16; ++j) { const unsigned c = xb_ld(&bar[XB_XCNT(j)]); sum += c; cnt += (c > 0u) ? 1u : 0u; mine = (j == x) ? c : mine; }
        if (sum == G) break;
        __builtin_amdgcn_s_sleep(1);
        if ((++sp & 255u) == 0u) { if (xb_ld(&bar[XB_TMO])) break; if (sp > XB_SPIN_CAP) { atomicAdd(&bar[XB_TMO], 1u); break; } }
    }
    nloc = mine > 0u ? mine : 1u; nx = cnt > 0u ? cnt : 1u;
}
__device__ __forceinline__ void xcd_barrier(const XcdBarrier& b, const int wv) {
    asm volatile("s_waitcnt vmcnt(0)" ::: "memory");
    __syncthreads();
    if (wv == 0 && lane_id() == 0) {
        unsigned* bar = b.bar;
        __builtin_amdgcn_s_waitcnt(0);
        unsigned nloc = b.st[0], nx = b.st[1];
        if (nloc == 0u) { xcd_barrier_complete(bar, b.x, nloc, nx); b.st[0] = nloc; b.st[1] = nx; }
        const unsigned old = xb_add(&bar[XB_XSUB(b.x)], 1u);
        const unsigned gen = old / nloc;
        if (old + 1u == (gen + 1u) * nloc) {
            __builtin_amdgcn_fence(__ATOMIC_RELEASE, "agent");
            asm volatile("s_waitcnt vmcnt(0)" ::: "memory");
            const unsigned og = xb_add(&bar[XB_TOP], 1u);
            const unsigned tg = og / nx;
            if (og + 1u == (tg + 1u) * nx) xb_add(&bar[XB_TOPGEN], 1u);
            else XB_SPIN(xb_ld(&bar[XB_TOPGEN]) == tg, bar);
            __builtin_amdgcn_fence(__ATOMIC_ACQUIRE, "agent");
            xb_add(&bar[XB_XGEN(b.x)], 1u);
            asm volatile("s_waitcnt vmcnt(0)" ::: "memory");
        } else {
            XB_SPIN(xb_ld(&bar[XB_XGEN(b.x)]) == gen, bar);
            __builtin_amdgcn_fence(__ATOMIC_ACQUIRE, "agent");
            asm volatile("s_waitcnt vmcnt(0)" ::: "memory");
        }
    }
    __syncthreads();
}

constexpr size_t MiB = 1u << 20;
constexpr size_t WS_CTL = 0, CTL_ZERO_BYTES = 1 * MiB;
constexpr size_t WS_WGU1 = 1 * MiB, WS_WD1 = 12 * MiB, WS_WGU2 = 18 * MiB, WS_WD2 = 29 * MiB, WS_WIN1 = 35 * MiB, WS_WGAB = 38 * MiB;
constexpr size_t WS_WUQ = 42 * MiB, WS_WUKV = 42 * MiB + 512 * 1024, WS_WM = 43 * MiB, WS_WA = 44 * MiB, WS_WB = 45 * MiB, WS_WOUT = 46 * MiB;
constexpr size_t WS_RSTD0 = 48 * MiB, WS_RSTD1 = WS_RSTD0 + 256 * 1024, WS_RSTD2 = WS_RSTD1 + 256 * 1024, WS_RSTDQ = WS_RSTD2 + 256 * 1024, WS_RSTDKV = 49 * MiB;
constexpr size_t WS_SS = 50 * MiB, WS_GATES = 54 * MiB;
constexpr size_t WS_X1B = 64 * MiB;
constexpr size_t WS_XB = 192 * MiB;
constexpr size_t WS_ACT = 320 * MiB;
constexpr size_t WS_PA = 320 * MiB;
constexpr size_t WS_OPRE = 384 * MiB;
constexpr size_t WS_Q = 448 * MiB;
constexpr size_t WS_K = 544 * MiB;
constexpr size_t WS_V = 640 * MiB;
constexpr size_t WS_MQKV = 704 * MiB;
constexpr size_t WS_HB = 896 * MiB;
constexpr size_t WS_GSC = 960 * MiB;
constexpr size_t WS_VT8 = 984 * MiB;
constexpr size_t WS_END = 1016 * MiB;
constexpr int CW_BAR = 4096;

struct CfgWin  { static constexpr size_t off0 = WS_XB, off1 = WS_PA, off2 = WS_PA; static constexpr int ld0 = 1024, ld1 = 512, ld2 = 512, c0 = 512, c1 = 256, c2 = 0, GPN = 2; static constexpr float POST = 1.f; static constexpr bool HP = false, GATES = true, RS = true, SSQ = true; };
struct CfgWin8 { static constexpr size_t off0 = WS_OPRE, off1 = WS_PA, off2 = WS_PA; static constexpr int ld0 = 512, ld1 = 512, ld2 = 512, c0 = 0, c1 = 0, c2 = 0, GPN = -1; static constexpr float POST = 1.f / 32.f; static constexpr bool HP = false, GATES = false, RS = true, SSQ = true; };
struct CfgQ    { static constexpr size_t off0 = WS_Q, off1 = WS_Q, off2 = WS_Q; static constexpr int ld0 = 768, ld1 = 768, ld2 = 768, c0 = 0, c1 = 512, c2 = 0; static constexpr int GPN = -1; static constexpr float POST = 1.f; static constexpr bool HP = false, GATES = false, RS = true, SSQ = false; };
struct CfgKV   { static constexpr size_t off0 = WS_K, off1 = WS_V, off2 = WS_V; static constexpr int ld0 = 768, ld1 = 512, ld2 = 512, c0 = 0, c1 = 0, c2 = 0; static constexpr int GPN = -1; static constexpr float POST = 1.f; static constexpr bool HP = true, GATES = false, RS = true, SSQ = false; };
struct CfgM    { static constexpr size_t off0 = WS_MQKV, off1 = WS_MQKV, off2 = WS_MQKV; static constexpr int ld0 = 1536, ld1 = 1536, ld2 = 1536, c0 = 0, c1 = 512, c2 = 1024; static constexpr int GPN = -1; static constexpr float POST = 1.f; static constexpr bool HP = false, GATES = false, RS = false, SSQ = false; };

constexpr int LDS_BYTES = 163840, RING_BYTES = 131072, MISC_OFF = LDS_BYTES - 256;
static_assert(ml::LDS_BYTES <= MISC_OFF, "mLSTM chain LDS map overlaps the barrier words");

struct Args {
    const float* x; const int* positions;
    const float *ffn1_norm_w, *ffn1_w_gate, *ffn1_w_up, *ffn1_w_down, *mix_norm_w, *w_in, *q_a_norm_w, *w_uq, *kv_a_norm_w, *w_uk, *w_uv, *q_norm_w, *k_norm_w, *w_branch_a,
                *conv_w, *conv_b, *w_mq, *w_mk, *w_mv, *b_igate, *b_fgate, *m_norm_w, *m_skip, *w_branch_b, *w_out, *ffn2_norm_w, *ffn2_w_gate, *ffn2_w_up, *ffn2_w_down, *final_norm_w;
    float* out; unsigned char* ws; int ph_lo, ph_hi;
};

template <int ID> __device__ __forceinline__ float wsrc(const Args& a, int n, int k) {
    if constexpr (ID == 0 || ID == 2) { const float* wg = ID == 0 ? a.ffn1_w_gate : a.ffn2_w_gate; const float* wu = ID == 0 ? a.ffn1_w_up : a.ffn2_w_up; const float* nw = ID == 0 ? a.ffn1_norm_w : a.ffn2_norm_w;
        const int pn = n >> 8, j = n & 255, col = 128 * pn + (j & 127); return (j < 128 ? wg : wu)[(size_t)k * FFN + col] * nw[k]; }
    else if constexpr (ID == 1 || ID == 3) { return (ID == 1 ? a.ffn1_w_down : a.ffn2_w_down)[(size_t)k * DM + n]; }
    else if constexpr (ID == 4) { int col;
        if (n < 512) col = 416 + n; else { const int j = n - 512; col = j < 128 ? 256 + j : (j < 160 ? 384 + (j - 128) : (j < 176 ? 1440 + (j - 160) : -1)); }
        return col >= 0 ? a.w_in[(size_t)k * IN_DIM + col] * a.mix_norm_w[k] : 0.f; }
    else if constexpr (ID == 12) { const int col = n < 512 ? 928 + n : n - 512;
        return a.w_in[(size_t)k * IN_DIM + col] * a.mix_norm_w[k]; }
    else if constexpr (ID == 5) { return a.w_in[(size_t)k * IN_DIM + 1456 + n] * a.mix_norm_w[k]; }
    else if constexpr (ID == 6) { return a.w_uq[(size_t)k * 768 + n] * a.q_a_norm_w[k]; }
    else if constexpr (ID == 7) { return (n < 512 ? a.w_uk[(size_t)k * 512 + n] : a.w_uv[(size_t)k * 512 + n - 512]) * a.kv_a_norm_w[k]; }
    else if constexpr (ID == 8) { const int T = n >> 9, r = n & 511, h = r >> 7, e = r & 127, hb = k >> 7; if (hb != (h & 1)) return 0.f;
        const float* w = T == 0 ? a.w_mq : (T == 1 ? a.w_mk : a.w_mv); const float v = w[((size_t)h * 128 + (k & 127)) * 128 + e]; return T == 1 ? v * 0.08838834764831845f : v; }
    else if constexpr (ID == 9) { return k < 512 ? a.w_branch_b[(size_t)k * DM + n] : a.w_branch_a[(size_t)(k - 512) * DM + n]; }
    else { return a.w_out[(size_t)k * DM + n]; }
}
template <int ID> __device__ __forceinline__ void wt_convert(const Args& a, bf16_t* WT, int N, int K, LAS float* scr, int gw, int NGW, int lane) {
    const int nblk = N / 32, items = (K / 64) * nblk;
    for (int item = gw; item < items; item += NGW) {
        const int kb = item / nblk, nb = item % nblk, k0 = 64 * kb, n0 = 32 * nb;
#pragma unroll 8
        for (int i = 0; i < 32; ++i) { const int kk = 2 * i + (lane >> 5); scr[kk * 33 + (lane & 31)] = wsrc<ID>(a, n0 + (lane & 31), k0 + kk); }
        asm volatile("s_waitcnt lgkmcnt(0)" ::: "memory");
        const int c = lane & 7;
#pragma unroll
        for (int j = 0; j < 4; ++j) { const int n = (lane >> 3) + 8 * j; const LAS float* s = scr + (8 * c) * 33 + n;
            u32x4 o; o.x = cvt_pk_bf16(s[0 * 33], s[1 * 33]); o.y = cvt_pk_bf16(s[2 * 33], s[3 * 33]); o.z = cvt_pk_bf16(s[4 * 33], s[5 * 33]); o.w = cvt_pk_bf16(s[6 * 33], s[7 * 33]);
            *(u32x4*)(WT + (size_t)(n0 + n) * K + k0 + 8 * c) = o; }
        asm volatile("s_waitcnt lgkmcnt(0)" ::: "memory");
    }
}

template <int ID> __device__ __forceinline__ void wt_convert8(const Args& a, unsigned char* WT8, int N, int K, float scale, LAS float* scr, int gw, int NGW, int lane) {
    const int nblk = N / 32, items = (K / 64) * nblk;
    for (int item = gw; item < items; item += NGW) {
        const int kb = item / nblk, nb = item % nblk, k0 = 64 * kb, n0 = 32 * nb;
#pragma unroll 8
        for (int i = 0; i < 32; ++i) { const int kk = 2 * i + (lane >> 5); scr[kk * 33 + (lane & 31)] = wsrc<ID>(a, n0 + (lane & 31), k0 + kk) * scale; }
        asm volatile("s_waitcnt lgkmcnt(0)" ::: "memory");
        const int c = lane & 7;
#pragma unroll
        for (int j = 0; j < 4; ++j) { const int n = (lane >> 3) + 8 * j; const LAS float* sp = scr + (8 * c) * 33 + n;
            *(u32x2*)(WT8 + (size_t)(n0 + n) * K + k0 + 8 * c) = (u32x2){pack4_fp8(sp[0 * 33], sp[1 * 33], sp[2 * 33], sp[3 * 33]), pack4_fp8(sp[4 * 33], sp[5 * 33], sp[6 * 33], sp[7 * 33])}; }
        asm volatile("s_waitcnt lgkmcnt(0)" ::: "memory");
    }
}

constexpr int NPHASE = 18;
__global__ void __launch_bounds__(512, 2) fwd_kernel(Args args) {
    extern __shared__ __attribute__((aligned(16))) unsigned char lds_raw[];
    LAS unsigned char* lds = (LAS unsigned char*)lds_raw;
    volatile LAS unsigned* MISC = (volatile LAS unsigned*)(lds + MISC_OFF);
    const int wave = __builtin_amdgcn_readfirstlane((int)threadIdx.x >> 6);
#define PH_TID() int lane = lane_id(); asm volatile("" : "+v"(lane)); const int tid = wave * 64 + lane; (void)tid
    const int G = gridDim.x, bx = blockIdx.x, vcu = (G % 8 == 0) ? (bx % 8) * (G / 8) + bx / 8 : bx;
    const int gw = vcu * 8 + wave, NGW = G * 8;
    unsigned char* ws = args.ws;
    unsigned* ctl = (unsigned*)(ws + WS_CTL);
    { PH_TID(); for (int u = tid; u < (LDS_BYTES - RING_BYTES) / 4; u += 512) ((LAS unsigned*)(lds + RING_BYTES))[u] = 0u; }
    __syncthreads();
    XcdBarrier bar = xcd_barrier_post(ctl + CW_BAR, MISC + 8, wave);
    const int lo = args.ph_lo, hi = args.ph_hi;
#define IN(k) (lo <= (k) && (k) < hi)
#define SEAM(k) do { if (IN(k) && IN((k) + 1)) xcd_barrier(bar, wave); } while (0)

#define Wgu1 ((bf16_t*)(ws + WS_WGU1))
#define Wd1 ((bf16_t*)(ws + WS_WD1))
#define Wgu2 ((bf16_t*)(ws + WS_WGU2))
#define Wd2 ((bf16_t*)(ws + WS_WD2))
#define Win1 ((bf16_t*)(ws + WS_WIN1))
#define Win8 ((bf16_t*)(ws + WS_WIN1 + 1536 * 1024))
#define Wgab ((bf16_t*)(ws + WS_WGAB))
#define Wuq ((bf16_t*)(ws + WS_WUQ))
#define Wukv ((bf16_t*)(ws + WS_WUKV))
#define Wm ((bf16_t*)(ws + WS_WM))
#define Wa ((bf16_t*)(ws + WS_WA))
#define Wb ((bf16_t*)(ws + WS_WB))
#define Wout ((bf16_t*)(ws + WS_WOUT))
#define rstd0 ((float*)(ws + WS_RSTD0))
#define rstd1 ((float*)(ws + WS_CTL + 256 * 1024))
#define rstd2 ((float*)(ws + WS_CTL + 512 * 1024))
#define ss3 ((float*)(ws + WS_CTL + 768 * 1024))
#define rstdq ((float*)(ws + WS_RSTDQ))
#define rstdkv ((float*)(ws + WS_RSTDKV))
#define ssb ((float*)(ws + WS_SS))
#define gatesb ((float*)(ws + WS_GATES))
#define x1b ((bf16_t*)(ws + WS_X1B))
#define xb ((bf16_t*)(ws + WS_XB))
#define xcm ((bf16_t*)(ws + WS_XB))
#define x2b ((bf16_t*)(ws + WS_XB))
#define act ((bf16_t*)(ws + WS_ACT))
#define pa ((bf16_t*)(ws + WS_PA))
#define hfb ((bf16_t*)(ws + WS_PA))
#define opre ((bf16_t*)(ws + WS_OPRE))
#define Qb ((bf16_t*)(ws + WS_Q))
#define bmb ((bf16_t*)(ws + WS_Q))
#define Kb ((bf16_t*)(ws + WS_K))
#define merged ((bf16_t*)(ws + WS_MQKV))
#define Vb ((bf16_t*)(ws + WS_V))
#define mqkv ((bf16_t*)(ws + WS_MQKV))
#define sig0_ ((bf16_t*)((unsigned char*)args.out + 64 * MiB))
#define sig1_ ((bf16_t*)(ws + WS_V) - (size_t)pg8::SIG_SPLIT_PM * 256 * 2048)
#define hbb ((bf16_t*)(ws + WS_HB))

    if (IN(0)) { PH_TID();
        LAS float* scr = (LAS float*)(lds + wave * 16384);
        wt_convert<0>(args, Wgu1, NGU, DM, scr, gw, NGW, lane);
        wt_convert<1>(args, Wd1, DM, FFN, scr, gw, NGW, lane);
        wt_convert<2>(args, Wgu2, NGU, DM, scr, gw, NGW, lane);
        wt_convert<3>(args, Wd2, DM, FFN, scr, gw, NGW, lane);
        wt_convert<4>(args, Win1, 768, DM, scr, gw, NGW, lane);
        wt_convert8<12>(args, (unsigned char*)Win8, 768, DM, 32.f, scr, gw, NGW, lane);
        wt_convert8<5>(args, (unsigned char*)Wgab, 2048, DM, 32.f, scr, gw, NGW, lane);
        wt_convert<6>(args, Wuq, 768, 256, scr, gw, NGW, lane);
        wt_convert<7>(args, Wukv, 1024, 128, scr, gw, NGW, lane);
        wt_convert<8>(args, Wm, 1536, 256, scr, gw, NGW, lane);
        wt_convert<9>(args, Wa, 1024, 1024, scr, gw, NGW, lane);
        wt_convert<11>(args, Wout, 1024, 1024, scr, gw, NGW, lane);
        for (int m4 = gw * 4; m4 < M; m4 += NGW * 4) {
            f32x4 v[4][4];
#pragma unroll
            for (int u = 0; u < 4; ++u) { const f32x4* xr = (const f32x4*)(args.x + (size_t)(m4 + u) * DM) + lane;
#pragma unroll
                for (int j = 0; j < 4; ++j) v[u][j] = xr[64 * j]; }
#pragma unroll
            for (int u = 0; u < 4; ++u) { float s = 0.f;
#pragma unroll
                for (int j = 0; j < 4; ++j) s += (v[u][j][0] * v[u][j][0] + v[u][j][1] * v[u][j][1]) + (v[u][j][2] * v[u][j][2] + v[u][j][3] * v[u][j][3]);
                s = wave_sum(s);
                u32x2* o8 = (u32x2*)(xb + (size_t)(m4 + u) * DM) + lane;
#pragma unroll
                for (int j = 0; j < 4; ++j) o8[64 * j] = (u32x2){cvt_pk_bf16(v[u][j][0], v[u][j][1]), cvt_pk_bf16(v[u][j][2], v[u][j][3])};
                if (lane == 0) rstd0[m4 + u] = s; }
        }
    }
    SEAM(0);
    if (IN(1)) { pg8::Gemm g{xb, Wgu1, M, NGU, DM, DM, DM, 0, 0}; pg8::StaticOrder S; S.init(M, NGU, G, bx); pg8::EpiSwiglu E{act, rstd0}; pg8::gemm_phase(lds, g, S, E, wave); }
    SEAM(1);
    if (IN(2)) { pg8::Gemm g{act, Wd1, M, DM, FFN, FFN, FFN, 0, 0}; pg8::StaticOrder S; S.init(M, DM, G, bx); pg8::EpiRes<false, true> E{xb, x1b, rstd1, 0.5f, (unsigned char*)args.out  }; pg8::gemm_phase(lds, g, S, E, wave); }
    SEAM(2);
    if (IN(4)) { pg8::Gemm g{x1b, Win1, M, 768, DM, DM, DM, 0, 0}; pg8::StaticOrder S; S.init(M, 768, G, bx);
        pg8::EpiStore<CfgWin> E{ws, rstd1, gatesb}; pg8::gemm_phase(lds, g, S, E, wave); }
    if (IN(4)) { pg8::Gemm g{(const bf16_t*)args.out, Win8, M, 768, DM / 2, DM / 2, DM / 2, 0, 0}; pg8::StaticOrder S; S.init(M, 768, G, bx);
        pg8::EpiStore<CfgWin8> E{ws, rstd1, nullptr}; pg8::gemm_phase<pg8::EpiStore<CfgWin8>, true>(lds, g, S, E, wave); }
    SEAM(4);
    if (IN(5)) { PH_TID();
        float cw[5][8], cb[8];
#pragma unroll
        for (int j = 0; j < 5; ++j)
#pragma unroll
            for (int e = 0; e < 8; ++e) cw[j][e] = args.conv_w[j * 512 + 8 * lane + e];
#pragma unroll
        for (int e = 0; e < 8; ++e) cb[e] = args.conv_b[8 * lane + e];
        for (int blk = gw; blk < M / 32; blk += NGW) {
            const int tb = blk * 32, sb = tb & (SEQ - 1); u32x4 xr[4];
#define CONV_ROW(dst, sp_, t_) do { if ((sp_) >= 0 && (sp_) < SEQ) dst = *(const u32x4*)(xcm + (size_t)(t_) * 1024 + 512 + 8 * lane); else dst = (u32x4){0u, 0u, 0u, 0u}; } while (0)
            CONV_ROW(xr[0], sb - 2, tb - 2); CONV_ROW(xr[1], sb - 1, tb - 1); CONV_ROW(xr[2], sb, tb); CONV_ROW(xr[3], sb + 1, tb + 1);
#define P5_LOADS(XN, CQ, CKV, k8) do { const int t8 = tb + (k8); _Pragma("unroll") for (int i = 0; i < 8; ++i) { CONV_ROW(XN[i], sb + (k8) + i + 2, t8 + i + 2); \
                    CQ[i] = *(const u32x2*)(pa + (size_t)(t8 + i) * 512 + 4 * lane); CKV[i] = *(const unsigned*)(pa + (size_t)(t8 + i) * 512 + 256 + 2 * lane); } } while (0)
#define P5_STEP(XN, CQ, CKV, k8) do { const int t8 = tb + (k8); \
                _Pragma("unroll") for (int i = 0; i < 8; ++i) { const int t = t8 + i; float y[8], xv[8]; \
                    _Pragma("unroll") for (int e = 0; e < 8; ++e) y[e] = cb[e]; \
                    _Pragma("unroll") for (int jj = 0; jj < 5; ++jj) { unpack8((i + jj < 4) ? xr[(i + jj) & 3] : XN[(i + jj - 4) & 7], xv); \
                        _Pragma("unroll") for (int e = 0; e < 8; ++e) y[e] += cw[jj][e] * xv[e]; } \
                    _Pragma("unroll") for (int e = 0; e < 8; ++e) y[e] = y[e] * sigmoidf_(y[e]); \
                    *(u32x4*)(xcm + (size_t)t * 1024 + 8 * lane) = pack8(y); \
                    const float q0 = __uint_as_float(CQ[i].x << 16), q1 = __uint_as_float(CQ[i].x & 0xffff0000u), q2 = __uint_as_float(CQ[i].y << 16), q3 = __uint_as_float(CQ[i].y & 0xffff0000u); \
                    const float k0 = __uint_as_float(CKV[i] << 16), k1 = __uint_as_float(CKV[i] & 0xffff0000u); \
                    const float sq = wave_sum((q0 * q0 + q1 * q1) + (q2 * q2 + q3 * q3)), sk = wave_sum(k0 * k0 + k1 * k1); \
                    if (lane == 0) { rstdq[t] = rsq_(sq * (1.f / 256.f) + EPS); rstdkv[t] = rsq_(sk * (1.f / 128.f) + EPS); } } \
                _Pragma("unroll") for (int i = 0; i < 4; ++i) xr[i] = XN[4 + i]; } while (0)
            { u32x4 xa[8], xb_[8]; u32x2 cqa[8], cqb[8]; unsigned cka[8], ckb[8];
              P5_LOADS(xa, cqa, cka, 0);
              P5_LOADS(xb_, cqb, ckb, 8);  P5_STEP(xa, cqa, cka, 0);
              P5_LOADS(xa, cqa, cka, 16);  P5_STEP(xb_, cqb, ckb, 8);
              P5_LOADS(xb_, cqb, ckb, 24); P5_STEP(xa, cqa, cka, 16);
              P5_STEP(xb_, cqb, ckb, 24); }
#undef P5_LOADS
#undef P5_STEP
#undef CONV_ROW
        }
    }
    SEAM(5);
    if (IN(6)) {
        { pg8::Gemm g{pa, Wuq, M, 768, 256, 512, 256, 0, 0}; pg8::StaticOrder S; S.init(M, 768, G, bx); pg8::EpiStore<CfgQ> E{ws, rstdq, nullptr}; pg8::gemm_phase(lds, g, S, E, wave); }
        { pg8::Gemm g{pa + 256, Wukv, M, 1024, 128, 512, 128, 0, 0}; pg8::StaticOrder S; S.init(M, 1024, G, bx); pg8::EpiStore<CfgKV> E{ws, rstdkv, nullptr}; pg8::gemm_phase(lds, g, S, E, wave); }
        { pg8::Gemm g{xcm, Wm, M, 1536, 256, 1024, 256, 256, 512}; pg8::StaticOrder S; S.init(M, 1536, G, bx); pg8::EpiStore<CfgM> E{ws, nullptr, nullptr}; pg8::gemm_phase(lds, g, S, E, wave); }
    }
    SEAM(6);
    if (IN(7)) { PH_TID();
        const int hh = lane >> 3, sub = lane & 7;
        const float inv0 = powf(10000.f, -(float)(2 * sub) / 16.f), inv1 = powf(10000.f, -(float)(2 * sub + 1) / 16.f);
        float qw[12], kw[12];
#pragma unroll
        for (int e = 0; e < 8; ++e) { qw[e] = args.q_norm_w[8 * sub + e]; kw[e] = args.k_norm_w[8 * sub + e]; }
#pragma unroll
        for (int e = 0; e < 2; ++e) { qw[8 + e] = args.q_norm_w[64 + 2 * sub + e]; qw[10 + e] = args.q_norm_w[80 + 2 * sub + e]; kw[8 + e] = args.k_norm_w[64 + 2 * sub + e]; kw[10 + e] = args.k_norm_w[80 + 2 * sub + e]; }
        const float qscale = 0.10206207261596577f * LOG2E;
        for (int t4 = gw * 4; t4 < M; t4 += NGW * 4) {
            u32x4 qv_[4], kv_[4]; unsigned qr1[4], qr2[4], kr1[4], kr2[4]; int ps_[4];
#pragma unroll
            for (int u = 0; u < 4; ++u) { const size_t t = (size_t)(t4 + u); const bf16_t* qb_ = Qb + t * 768 + hh * 96; const bf16_t* kb_ = Kb + t * 768 + hh * 96;
                ps_[u] = args.positions[t]; qv_[u] = *(const u32x4*)(qb_ + 8 * sub); qr1[u] = *(const unsigned*)(qb_ + 64 + 2 * sub); qr2[u] = *(const unsigned*)(qb_ + 80 + 2 * sub);
                kv_[u] = *(const u32x4*)(kb_ + 8 * sub); kr1[u] = *(const unsigned*)(pa + t * 512 + 384 + 2 * sub); kr2[u] = *(const unsigned*)(pa + t * 512 + 400 + 2 * sub); }
#pragma unroll
            for (int u = 0; u < 4; ++u) { const size_t t = (size_t)(t4 + u);
            const float pos = (float)ps_[u];
            float c0, s0, c1, s1;
            { const float C = 0.15915494f, CL = 6.4206383e-09f; const float t0 = pos * inv0, t1 = pos * inv1;
              const float h0 = t0 * C, h1 = t1 * C; const float l0 = __builtin_fmaf(t0, C, -h0) + t0 * CL, l1 = __builtin_fmaf(t1, C, -h1) + t1 * CL;
              const float f0 = (h0 - floorf(h0)) + l0, f1 = (h1 - floorf(h1)) + l1;
              s0 = __builtin_amdgcn_sinf(f0); c0 = __builtin_amdgcn_cosf(f0); s1 = __builtin_amdgcn_sinf(f1); c1 = __builtin_amdgcn_cosf(f1); }
            { bf16_t* base = Qb + t * 768 + hh * 96; float v[8]; unpack8(qv_[u], v);
              const unsigned r1 = qr1[u], r2 = qr2[u];
              float x1a = __uint_as_float(r1 << 16), x1b_ = __uint_as_float(r1 & 0xffff0000u), x2a = __uint_as_float(r2 << 16), x2b_ = __uint_as_float(r2 & 0xffff0000u);
              float sq = (x1a * x1a + x1b_ * x1b_) + (x2a * x2a + x2b_ * x2b_);
#pragma unroll
              for (int e = 0; e < 8; ++e) sq += v[e] * v[e];
              sq += __shfl_xor(sq, 1); sq += __shfl_xor(sq, 2); sq += __shfl_xor(sq, 4);
              const float rn = rsq_(sq * (1.f / 96.f) + EPS) * qscale;
#pragma unroll
              for (int e = 0; e < 8; ++e) v[e] = v[e] * (rn * 8.f) * qw[e];
              x1a = x1a * rn * qw[8]; x1b_ = x1b_ * rn * qw[9]; x2a = x2a * rn * qw[10]; x2b_ = x2b_ * rn * qw[11];
              *(u32x2*)((char*)base + 8 * sub) = (u32x2){pack4_fp8(v[0], v[1], v[2], v[3]), pack4_fp8(v[4], v[5], v[6], v[7])};
              *(unsigned*)(base + 64 + 2 * sub) = cvt_pk_bf16(x1a * c0 - x2a * s0, x1b_ * c1 - x2b_ * s1);
              *(unsigned*)(base + 80 + 2 * sub) = cvt_pk_bf16(x2a * c0 + x1a * s0, x2b_ * c1 + x1b_ * s1); }
            { bf16_t* base = Kb + t * 768 + hh * 96; float v[8]; unpack8(kv_[u], v);
              const unsigned r1 = kr1[u], r2 = kr2[u];
              float x1a = __uint_as_float(r1 << 16), x1b_ = __uint_as_float(r1 & 0xffff0000u), x2a = __uint_as_float(r2 << 16), x2b_ = __uint_as_float(r2 & 0xffff0000u);
              float sq = (x1a * x1a + x1b_ * x1b_) + (x2a * x2a + x2b_ * x2b_);
#pragma unroll
              for (int e = 0; e < 8; ++e) sq += v[e] * v[e];
              sq += __shfl_xor(sq, 1); sq += __shfl_xor(sq, 2); sq += __shfl_xor(sq, 4);
              const float rn = rsq_(sq * (1.f / 96.f) + EPS);
#pragma unroll
              for (int e = 0; e < 8; ++e) v[e] = v[e] * rn * kw[e];
              x1a = x1a * rn * kw[8]; x1b_ = x1b_ * rn * kw[9]; x2a = x2a * rn * kw[10]; x2b_ = x2b_ * rn * kw[11];
              *(u32x2*)((char*)base + 8 * sub) = (u32x2){pack4_fp8(v[0], v[1], v[2], v[3]), pack4_fp8(v[4], v[5], v[6], v[7])};
              *(unsigned*)(base + 64 + 2 * sub) = cvt_pk_bf16(x1a * c0 - x2a * s0, x1b_ * c1 - x2b_ * s1);
              *(unsigned*)(base + 80 + 2 * sub) = cvt_pk_bf16(x2a * c0 + x1a * s0, x2b_ * c1 + x1b_ * s1); }
            }
        }
        for (int task = gw; task < 8192; task += NGW) { const int bh = task >> 7, tl = task & 127;
            const bf16_t* vp = Vb + ((size_t)(bh >> 3) * SEQ + (size_t)tl * 64) * 512 + (bh & 7) * 64 + lane; bf16_t vv[64];
#pragma unroll
            for (int k = 0; k < 64; ++k) vv[k] = vp[(size_t)k * 512];
            unsigned char* dst = ws + WS_VT8 + (size_t)task * 4096 + lane * 64;
#pragma unroll
            for (int c = 0; c < 4; ++c) { const int hh = c >> 1, half = c & 1; u32x4 w;
#define VT_W(a) pack4_fp8(bf2f(vv[32 * half + 8 * (a) + 4 * hh]), bf2f(vv[32 * half + 8 * (a) + 4 * hh + 1]), bf2f(vv[32 * half + 8 * (a) + 4 * hh + 2]), bf2f(vv[32 * half + 8 * (a) + 4 * hh + 3]))
                w.x = VT_W(0); w.y = VT_W(1); w.z = VT_W(2); w.w = VT_W(3);
#undef VT_W
                *(u32x4*)(dst + ((c ^ ((lane >> 2) & 3)) << 4)) = w; }
        }
        for (int task = gw; task < 4096; task += NGW) { const int bhd = task >> 6, cs = task & 63, b = bhd >> 3, h = (bhd >> 1) & 3, dir = bhd & 1;
            ml::gate_scan(gatesb, b, h, dir, cs, args.b_igate[dir * 4 + h], args.b_fgate[dir * 4 + h], (float*)(ws + WS_GSC) + (size_t)task * 384, (float*)(ws + WS_GSC) + (size_t)4096 * 384 + task * 2, lane); }
    }
    SEAM(7);
    if (IN(8)) {
#define ATT_UNIT(bh_, qb_) do { const int b_ = (bh_) >> 3, h_ = (bh_) & 7; const size_t row0 = (size_t)b_ * SEQ; \
            if (nomax) att::attn_unit2<true>(Qb + (row0 + (size_t)(qb_) * 256) * 768 + h_ * 96, Kb + row0 * 768 + h_ * 96, ws + WS_VT8 + (size_t)(bh_) * (128 * 4096), xcm + (row0 + (size_t)(qb_) * 256) * 1024 + 512 + h_ * 64, SEQ, (char*)lds_raw, wave); \
            else att::attn_unit2<false>(Qb + (row0 + (size_t)(qb_) * 256) * 768 + h_ * 96, Kb + row0 * 768 + h_ * 96, ws + WS_VT8 + (size_t)(bh_) * (128 * 4096), xcm + (row0 + (size_t)(qb_) * 256) * 1024 + 512 + h_ * 64, SEQ, (char*)lds_raw, wave); } while (0)
#define CHAIN_UNIT(u_) do { const int dir = (u_) & 1, h = ((u_) >> 1) & 3, b = (u_) >> 3; \
            const int bhd = (b * 4 + h) * 2 + dir; ml::chain(lds, b, h, dir, mqkv, dir ? hbb : hfb, (const float*)(ws + WS_GSC) + (size_t)bhd * (64 * 384), (const float*)(ws + WS_GSC) + (size_t)4096 * 384 + bhd * 128, wave); __syncthreads(); } while (0)
        bool nomax; { const int l_ = lane_id(); float wq = 0.f, wk = 0.f;
            for (int e = l_; e < 96; e += 64) { wq = fmaxf(wq, fabsf(args.q_norm_w[e])); wk = fmaxf(wk, fabsf(args.k_norm_w[e])); }
#pragma unroll
            for (int o = 1; o < 64; o <<= 1) { wq = fmaxf(wq, __shfl_xor(wq, o)); wk = fmaxf(wk, __shfl_xor(wk, o)); }
            const float bound = 9.797959f * 1.02f * LOG2E * wq * wk;
            nomax = __builtin_amdgcn_readfirstlane((int)(bound <= 19.5f)) != 0; }
        const bool fast = (G == 256); const int x = vcu >> 5, j = vcu & 31; const bool chainwg = fast ? ((j & 3) == 0) : true;
        const int kr = j - (j >> 2) - 1;
        for (int u = fast ? (chainwg ? (vcu >> 2) : 64) : vcu; u < 64; u += (fast ? 64 : G)) CHAIN_UNIT(u);
        const int nit = fast ? (chainwg ? 5 : 9) : (2048 - vcu + G - 1) / G;
        for (int it = 0; it < nit; ++it) { int bh, qb;
            if (fast) { const int s = it + (chainwg ? 4 : 0); if (s < 4) { const int idx = s * 24 + kr; bh = 8 * (idx >> 5) + x; qb = idx & 31; } else { bh = 8 * (s - 1) + x; qb = j; } }
            else { const int u = vcu + it * G; bh = u >> 5; qb = u & 31; }
            ATT_UNIT(bh, qb); }
#undef ATT_UNIT
#undef CHAIN_UNIT
        { pg8::Gemm g{(const bf16_t*)args.out, Wgab, M, 2048, DM / 2, DM / 2, DM / 2, 0, 0}; pg8::StaticOrder S; S.init(M, 2048, G, bx);
          if (fast) { S.n_all = 0; S.nh = 192; S.hv = chainwg ? -1 : (x * 24 + kr); }
          pg8::EpiSig E{sig0_, sig1_, rstd1, 1.f / 32.f};
          pg8::gemm_phase<pg8::EpiSig, true>(lds, g, S, E, wave); }
    }
    SEAM(8);
#if defined(ATT_SELFCHECK)
    if (IN(8)) { PH_TID();
        for (int smp = gw; smp < 4096; smp += NGW) {
            const int b = smp & 7, h = (smp >> 3) & 7, r = (((smp >> 6) * 129) + (smp & 63) * 1031 + (smp >> 6) * 4) & 8191;
            const size_t row = (size_t)b * SEQ + r;
            const bf16_t* qp = Qb + row * 768 + h * 96;
            float l = 0.f, acc[64];
#pragma unroll
            for (int e = 0; e < 64; ++e) acc[e] = 0.f;
            for (int kk = lane; kk < SEQ; kk += 64) {
                const bf16_t* kp = Kb + ((size_t)b * SEQ + kk) * 768 + h * 96; float sc_ = 0.f;
#pragma unroll
                for (int c = 0; c < 16; ++c) { const int qw_ = ((const int*)qp)[c], kw_ = ((const int*)kp)[c];
                    sc_ += 0.125f * (__builtin_amdgcn_cvt_f32_fp8(qw_, 0) * __builtin_amdgcn_cvt_f32_fp8(kw_, 0) + __builtin_amdgcn_cvt_f32_fp8(qw_, 1) * __builtin_amdgcn_cvt_f32_fp8(kw_, 1)
                                     + __builtin_amdgcn_cvt_f32_fp8(qw_, 2) * __builtin_amdgcn_cvt_f32_fp8(kw_, 2) + __builtin_amdgcn_cvt_f32_fp8(qw_, 3) * __builtin_amdgcn_cvt_f32_fp8(kw_, 3)); }
#pragma unroll
                for (int c = 8; c < 12; ++c) { float qf[8], kf[8]; unpack8(*(const u32x4*)(qp + 8 * c), qf); unpack8(*(const u32x4*)(kp + 8 * c), kf);
#pragma unroll
                    for (int e = 0; e < 8; ++e) sc_ += qf[e] * kf[e]; }
                const float p = exp2f(sc_ + att::POFF), pq = __builtin_amdgcn_cvt_f32_bf8(__builtin_amdgcn_cvt_pk_bf8_f32(p, p, 0, false), 0); l += p;
                { const int kin = kk & 63, half = kin >> 5, hh = (kin >> 2) & 1, a_ = (kin & 31) >> 3, ii = kin & 3, c = 2 * hh + half;
                  const unsigned char* vt = ws + WS_VT8 + ((size_t)((b * 8 + h) * 128 + (kk >> 6))) * 4096 + 4 * a_ + ii;
#pragma unroll
                  for (int d = 0; d < 64; ++d) acc[d] += pq * __builtin_amdgcn_cvt_f32_fp8((int)vt[d * 64 + ((c ^ ((d >> 2) & 3)) << 4)], 0); }
            }
            const float fs = 1.f; l = wave_sum(l);
            const bf16_t* ap = xcm + row * 1024 + 512 + h * 64; float err = 0.f, scl = 0.f;
#pragma unroll
            for (int e = 0; e < 64; ++e) { const float ref = wave_sum(acc[e] * fs) / l, got = bf2f(ap[e]); err = fmaxf(err, fabsf(got - ref)); scl = fmaxf(scl, fabsf(ref)); }
            if (lane == 0 && !(err <= (float)(ATT_SELFCHECK) * scl)) atomicAdd(ctl + CW_BAR + XB_TMO, 1u);
        }
    }
    if (IN(8) && IN(9)) xcd_barrier(bar, wave);
#endif
    if (IN(9)) { PH_TID();
        float nw[8], sk[8];
#pragma unroll
        for (int e = 0; e < 8; ++e) { nw[e] = args.m_norm_w[8 * lane + e]; sk[e] = args.m_skip[8 * lane + e]; }
        for (int t4 = gw * 4; t4 < M; t4 += NGW * 4) {
            u32x4 ra[4], rb[4], ro[4], rx[4];
#pragma unroll
            for (int u = 0; u < 4; ++u) { const size_t t = (size_t)(t4 + u);
                ra[u] = *(const u32x4*)(hfb + t * 512 + 8 * lane); rb[u] = *(const u32x4*)(hbb + t * 512 + 8 * lane);
                ro[u] = *(const u32x4*)(opre + t * 512 + 8 * lane); rx[u] = *(const u32x4*)(xcm + t * 1024 + 8 * lane); }
#pragma unroll
            for (int u = 0; u < 4; ++u) { float a[8], b[8], o[8], xv[8]; unpack8(ra[u], a); unpack8(rb[u], b); unpack8(ro[u], o); unpack8(rx[u], xv);
                float sq = 0.f;
#pragma unroll
                for (int e = 0; e < 8; ++e) { a[e] += b[e]; sq += a[e] * a[e]; }
                sq += __shfl_xor(sq, 1); sq += __shfl_xor(sq, 2); sq += __shfl_xor(sq, 4); sq += __shfl_xor(sq, 8);
                const float rn = rsq_(sq * (1.f / 128.f) + EPS);
#pragma unroll
                for (int e = 0; e < 8; ++e) a[e] = sigmoidf_(o[e]) * (a[e] * rn * nw[e] + sk[e] * xv[e]);
                *(u32x4*)(xcm + (size_t)(t4 + u) * 1024 + 8 * lane) = pack8(a); }
        }
    }
    SEAM(9);
    if (IN(11)) { pg8::Gemm g{xcm, Wa, M, DM, DM, DM, DM, 0, 0}; pg8::StaticOrder S; S.init(M, DM, G, bx); pg8::EpiMerge E{merged, sig0_, sig1_}; pg8::gemm_phase(lds, g, S, E, wave); }
    SEAM(11);
    if (IN(12)) { pg8::Gemm g{merged, Wout, M, DM, DM, DM, DM, 0, 0}; pg8::StaticOrder S; S.init(M, DM, G, bx); pg8::EpiRes<false> E{x1b, x2b, rstd2, 1.0f, nullptr}; pg8::gemm_phase(lds, g, S, E, wave); }
    SEAM(12);
    if (IN(14)) { pg8::Gemm g{x2b, Wgu2, M, NGU, DM, DM, DM, 0, 0}; pg8::StaticOrder S; S.init(M, NGU, G, bx); pg8::EpiSwiglu E{act, rstd2}; pg8::gemm_phase(lds, g, S, E, wave); }
    SEAM(14);
    if (IN(15)) { pg8::Gemm g{act, Wd2, M, DM, FFN, FFN, FFN, 0, 0}; pg8::StaticOrder S; S.init(M, DM, G, bx); pg8::EpiRes<false> E{x2b, x1b  , ss3, 0.5f, nullptr}; pg8::gemm_phase(lds, g, S, E, wave); }
    SEAM(15);
    if (IN(16)) { PH_TID();
        f32x4 fw[4];
#pragma unroll
        for (int j = 0; j < 4; ++j) fw[j] = ((const f32x4*)args.final_norm_w)[lane + 64 * j];
        const bool poison = __hip_atomic_load(ctl + CW_BAR + XB_TMO, __ATOMIC_RELAXED, __HIP_MEMORY_SCOPE_AGENT) != 0u;
        for (int m8 = gw * 8; m8 < M; m8 += NGW * 8) {
            u32x2 v[8][4]; float sv[8];
#pragma unroll
            for (int u = 0; u < 8; ++u) { const u32x2* xr = (const u32x2*)(x1b + (size_t)(m8 + u) * DM) + lane; sv[u] = ss3[m8 + u];
#pragma unroll
                for (int j = 0; j < 4; ++j) v[u][j] = xr[64 * j]; }
#pragma unroll
            for (int u = 0; u < 8; ++u) { const float rn = poison ? __builtin_nanf("") : rsq_(sv[u] * (1.f / DM) + EPS);
                f32x4* orow = (f32x4*)(args.out + (size_t)(m8 + u) * DM) + lane;
#pragma unroll
                for (int j = 0; j < 4; ++j) { const f32x4 x_ = (f32x4){__uint_as_float(v[u][j].x << 16), __uint_as_float(v[u][j].x & 0xffff0000u), __uint_as_float(v[u][j].y << 16), __uint_as_float(v[u][j].y & 0xffff0000u)};
                    __builtin_nontemporal_store(x_ * rn * fw[j], orow + 64 * j); } }
        }
    }
#if defined(DBG_STOP)
    if (lo <= 99 && 99 < hi) { PH_TID();
        const bf16_t* src16 = (const bf16_t*)(ws + (size_t)DBG_LO * MiB); const size_t n16 = ((size_t)(DBG_HI - DBG_LO) * MiB) / 2, NOUT = (size_t)M * DM;
        for (size_t e = (size_t)bx * 512 + tid; e < NOUT; e += (size_t)G * 512) { float s = 0.f; for (size_t j = e; j < n16; j += NOUT) s += bf2f(src16[j]); args.out[e] = s; }
    }
#endif
#undef IN
#undef SEAM
}

extern "C" void kernel_launch(void* const* d_in, const int* in_sizes, int n_in, void* d_out, int out_size, void* d_ws, size_t ws_size, hipStream_t stream) {
    static int grid = 0;
    if (grid == 0) {
        if (n_in != 32 || in_sizes[0] != M * DM || out_size != M * DM || ws_size < WS_END) {
            fprintf(stderr, "kernel_launch: built for 32 inputs, x/out of %d floats, >= %zu bytes of workspace; got n_in %d, in0 %d, out %d, ws %zu\n", M * DM, (size_t)WS_END, n_in, n_in > 0 ? in_sizes[0] : -1, out_size, ws_size);
            grid = -1; return; }
        int dev = 0, cus = 0, per_cu = 0;
        if (hipGetDevice(&dev) != hipSuccess || hipDeviceGetAttribute(&cus, hipDeviceAttributeMultiprocessorCount, dev) != hipSuccess) { grid = -1; return; }
        if (hipFuncSetAttribute((const void*)fwd_kernel, hipFuncAttributeMaxDynamicSharedMemorySize, LDS_BYTES) != hipSuccess) { fprintf(stderr, "kernel_launch: hipFuncSetAttribute failed\n"); grid = -1; return; }
        if (hipOccupancyMaxActiveBlocksPerMultiprocessor(&per_cu, (const void*)fwd_kernel, 512, LDS_BYTES) != hipSuccess || per_cu < 1)
            fprintf(stderr, "kernel_launch: note: occupancy query reports %d workgroups per CU\n", per_cu);
        (void)hipGetLastError();
        grid = cus;
    }
    if (grid < 0) return;
    (void)hipMemsetAsync((char*)d_ws + WS_CTL, 0, CTL_ZERO_BYTES, stream);
    Args a{};
    a.x = (const float*)d_in[0]; a.positions = (const int*)d_in[1];
    const float** fp = &a.ffn1_norm_w;
    for (int i = 0; i < 30; ++i) fp[i] = (const float*)d_in[2 + i];
    a.out = (float*)d_out; a.ws = (unsigned char*)d_ws;
#ifndef MK_PER_PHASE
#define MK_PER_PHASE 0
#endif
#if defined(DBG_STOP)
    for (int p = 0; p <= DBG_STOP; ++p) { a.ph_lo = p; a.ph_hi = p + 1; hipLaunchKernelGGL(fwd_kernel, dim3(grid), dim3(512), LDS_BYTES, stream, a); }
    a.ph_lo = 99; a.ph_hi = 100; hipLaunchKernelGGL(fwd_kernel, dim3(grid), dim3(512), LDS_BYTES, stream, a);
    return;
#endif
    if (MK_PER_PHASE) { for (int p = 0; p < NPHASE - 1; ++p) { a.ph_lo = p; a.ph_hi = p + 1; hipLaunchKernelGGL(fwd_kernel, dim3(grid), dim3(512), LDS_BYTES, stream, a); } }
    else { a.ph_lo = 0; a.ph_hi = NPHASE; hipLaunchKernelGGL(fwd_kernel, dim3(grid), dim3(512), LDS_BYTES, stream, a); }
    const hipError_t le = hipPeekAtLastError();
    if (le != hipSuccess) fprintf(stderr, "kernel_launch: launch failed: %s\n", hipGetErrorName(le));
}
```
